# Optimizing an MI355X kernel written in HIP

```python
import jax, jax.numpy as jnp
from jax import lax
import numpy as np

D_MODEL = 2048
BATCH = 4
SEQ = 2048
DEPTH = 2
DEC_BATCH = 8
DEC_SEQ = 8
PAST_LEN = 16384
PAGE_SIZE = 128

CONV_WIDTH = D_MODEL // 4
CONV_K = 3
ATT_WIDTH = D_MODEL // 4
ATT_HEADS_PER_GROUP = 4
ATT_HEAD_DIM = ATT_WIDTH // ATT_HEADS_PER_GROUP
DIL_GROUPS = ((128, 1), (512, 4), (2048, 16))
N_DIL = len(DIL_GROUPS)
N_ATT_HEADS = N_DIL * ATT_HEADS_PER_GROUP
POOL_WIDTH = D_MODEL - CONV_WIDTH - ATT_WIDTH
POOL_WINDOWS = (2, 4, 8, 16)
POOL_GROUP = POOL_WIDTH // len(POOL_WINDOWS)
POOL_BUF = max(POOL_WINDOWS) - 1
A_COLS = 3 * CONV_WIDTH
B_COLS = N_DIL * 3 * ATT_WIDTH
IN_COLS = A_COLS + B_COLS + POOL_WIDTH
D_FF = ((8 * D_MODEL // 3 + 127) // 128) * 128
FFN_CONV_K = 3
RMS_EPS = 1e-6

kernel_name = "hymba_conv_dilattn_pool_decoder_step"


def rms_norm(x, g):
    xf = x.astype(jnp.float32)
    y = xf * lax.rsqrt(jnp.mean(xf * xf, axis=-1, keepdims=True) + RMS_EPS)
    return (y * g.astype(jnp.float32)).astype(x.dtype)


def alibi_slopes():
    h = np.arange(1, N_ATT_HEADS + 1, dtype=np.float32)
    return jnp.asarray(np.power(np.float32(2.0), -8.0 * h / N_ATT_HEADS), dtype=jnp.float32)


def causal_dwconv(u, buf, w):
    k = w.shape[0]
    t = u.shape[1]
    ext = jnp.concatenate([buf.astype(u.dtype), u], axis=1)
    y = ext[:, 0:t] * w[0]
    for j in range(1, k):
        y = y + ext[:, j:j + t] * w[j]
    return y, ext[:, ext.shape[1] - (k - 1):]


def dilated_attention(q, k_ext, v_ext, start, window, dilation, slopes):
    t = q.shape[1]
    offs = jnp.arange(window // dilation + 1, dtype=jnp.int32)
    qf = q.astype(jnp.float32) * (ATT_HEAD_DIM ** -0.5)
    q_pos = start + jnp.arange(t, dtype=jnp.int32)

    def rows(ext, j):
        return lax.dynamic_slice_in_dim(ext, window - j * dilation, t, axis=1).astype(jnp.float32)

    def score(j):
        dist = j * dilation
        s = jnp.einsum("bthd,bthd->bth", qf, rows(k_ext, j)) - slopes * dist.astype(jnp.float32)
        ok = (q_pos - dist) >= 0
        return jnp.where(ok[None, :, None], s, -jnp.inf)

    s = lax.map(score, offs)
    m = jnp.max(s, axis=0)
    p = jnp.exp(s - m)
    l = jnp.sum(p, axis=0)

    def acc_step(acc, inp):
        j, pj = inp
        return acc + pj[..., None] * rows(v_ext, j), None

    acc, _ = lax.scan(acc_step, jnp.zeros(qf.shape, jnp.float32), (offs, p))
    return acc / l[..., None], m + jnp.log(l)


def multiscale_pool(u, buf, start, w_pool, scale):
    b, t, _ = u.shape
    ext = jnp.concatenate([buf.astype(u.dtype), u], axis=1).astype(jnp.float32)
    cs = jnp.pad(jnp.cumsum(ext, axis=1), ((0, 0), (1, 0), (0, 0)))
    pos = start + jnp.arange(t, dtype=jnp.int32)
    means = []
    for gi, w in enumerate(POOL_WINDOWS):
        sl = slice(gi * POOL_GROUP, (gi + 1) * POOL_GROUP)
        hi = cs[:, POOL_BUF + 1:POOL_BUF + 1 + t, sl]
        lo = cs[:, POOL_BUF + 1 - w:POOL_BUF + 1 - w + t, sl]
        cnt = jnp.minimum(w, pos + 1).astype(jnp.float32)
        means.append((hi - lo) / cnt[None, :, None])
    d = (jnp.concatenate(means, axis=-1) - u.astype(jnp.float32)).reshape(b, t, len(POOL_WINDOWS), POOL_GROUP)
    z = jnp.einsum("btgc,gcd->btgd", d, w_pool.astype(jnp.float32)).reshape(b, t, POOL_WIDTH)
    z = z * scale.astype(jnp.float32)
    return z.astype(u.dtype), ext[:, ext.shape[1] - POOL_BUF:].astype(u.dtype)


def decoder_layer(x, bufs, params, slopes, start):
    conv_buf, kv_bufs, pool_buf, ffn_buf = bufs
    (norm1, w_in, conv_a_w, w_out, pool_w, pool_scale, norm2, w_gate, w_up, ffn_conv_w, w_down) = params
    b, t, _ = x.shape
    h = rms_norm(x, norm1)
    proj = h @ w_in

    xa = proj[..., 0:CONV_WIDTH]
    gate_b = proj[..., CONV_WIDTH:2 * CONV_WIDTH]
    gate_c = proj[..., 2 * CONV_WIDTH:3 * CONV_WIDTH]
    cu, new_conv = causal_dwconv(gate_c * xa, conv_buf, conv_a_w)
    ya = gate_b * cu

    att = proj[..., A_COLS:A_COLS + B_COLS].reshape(b, t, N_DIL, 3, ATT_HEADS_PER_GROUP, ATT_HEAD_DIM)
    outs, lses, new_kv = [], [], []
    for g, (win, dil) in enumerate(DIL_GROUPS):
        q = att[:, :, g, 0]
        kv = att[:, :, g, 1:3]
        buf = kv_bufs[g].astype(kv.dtype)
        pad = jnp.zeros((b, win - buf.shape[1], 2, ATT_HEADS_PER_GROUP, ATT_HEAD_DIM), kv.dtype)
        ext = jnp.concatenate([pad, buf, kv], axis=1)
        o, lse = dilated_attention(q, ext[:, :, 0], ext[:, :, 1], start, win, dil,
                                   slopes[g * ATT_HEADS_PER_GROUP:(g + 1) * ATT_HEADS_PER_GROUP])
        outs.append(o)
        lses.append(lse)
        keep = min(win, start + t)
        new_kv.append(ext[:, win + t - keep:])
    alpha = jax.nn.softmax(jnp.stack(lses), axis=0)
    yb = jnp.sum(alpha[..., None] * jnp.stack(outs), axis=0).reshape(b, t, ATT_WIDTH).astype(x.dtype)

    yc, new_pool = multiscale_pool(proj[..., A_COLS + B_COLS:], pool_buf, start, pool_w, pool_scale)

    x = x + jnp.concatenate([ya, yb, yc], axis=-1) @ w_out

    h2 = rms_norm(x, norm2)
    gc, new_ffn = causal_dwconv(h2 @ w_gate, ffn_buf, ffn_conv_w)
    x = x + (jax.nn.silu(gc) * (h2 @ w_up)) @ w_down
    return x, (new_kv[0], new_kv[1], new_kv[2], new_conv, new_pool, new_ffn)


def setup_inputs(seed: int = 0) -> dict:
    key = jax.random.key(seed)
    ks = jax.random.split(key, 24)
    f32 = jnp.float32

    def nrm(k, shape, s):
        return jax.random.normal(k, shape, f32) * s

    hh, dh = ATT_HEADS_PER_GROUP, ATT_HEAD_DIM
    return {
        "x_prompt": nrm(ks[0], (BATCH, SEQ, D_MODEL), 1.0),
        "x_sample": nrm(ks[1], (DEC_BATCH, DEC_SEQ, D_MODEL), 1.0),
        "cache_kv_w128": nrm(ks[2], (DEPTH, DEC_BATCH, min(DIL_GROUPS[0][0], PAST_LEN), 2, hh, dh), 1.0),
        "cache_kv_w512": nrm(ks[3], (DEPTH, DEC_BATCH, min(DIL_GROUPS[1][0], PAST_LEN), 2, hh, dh), 1.0),
        "cache_kv_w2048": nrm(ks[4], (DEPTH, DEC_BATCH, min(DIL_GROUPS[2][0], PAST_LEN), 2, hh, dh), 1.0),
        "state_conv_a": nrm(ks[5], (DEPTH, DEC_BATCH, CONV_K - 1, CONV_WIDTH), 1.0),
        "state_pool": nrm(ks[6], (DEPTH, DEC_BATCH, POOL_BUF, POOL_WIDTH), 1.0),
        "state_ffn_conv": nrm(ks[7], (DEPTH, DEC_BATCH, FFN_CONV_K - 1, D_FF), 1.0),
        "norm1": 1.0 + nrm(ks[8], (DEPTH, D_MODEL), 0.05),
        "w_in": nrm(ks[9], (DEPTH, D_MODEL, IN_COLS), D_MODEL ** -0.5),
        "conv_a_w": nrm(ks[10], (DEPTH, CONV_K, CONV_WIDTH), CONV_K ** -0.5),
        "w_out": nrm(ks[11], (DEPTH, D_MODEL, D_MODEL), D_MODEL ** -0.5),
        "pool_w": nrm(ks[12], (DEPTH, len(POOL_WINDOWS), POOL_GROUP, POOL_GROUP), POOL_GROUP ** -0.5),
        "pool_scale": 1.0 + nrm(ks[13], (DEPTH, POOL_WIDTH), 0.1),
        "norm2": 1.0 + nrm(ks[14], (DEPTH, D_MODEL), 0.05),
        "w_gate": nrm(ks[15], (DEPTH, D_MODEL, D_FF), D_MODEL ** -0.5),
        "w_up": nrm(ks[16], (DEPTH, D_MODEL, D_FF), D_MODEL ** -0.5),
        "ffn_conv_w": nrm(ks[17], (DEPTH, FFN_CONV_K, D_FF), FFN_CONV_K ** -0.5),
        "w_down": nrm(ks[18], (DEPTH, D_FF, D_MODEL), D_FF ** -0.5),
        "final_norm": 1.0 + nrm(ks[19], (D_MODEL,), 0.05),
    }


def reference(x_prompt, x_sample, cache_kv_w128, cache_kv_w512, cache_kv_w2048, state_conv_a, state_pool,
              state_ffn_conv, norm1, w_in, conv_a_w, w_out, pool_w, pool_scale, norm2, w_gate, w_up,
              ffn_conv_w, w_down, final_norm):
    slopes = alibi_slopes()
    kv_caches = (cache_kv_w128, cache_kv_w512, cache_kv_w2048)
    hh, dh = ATT_HEADS_PER_GROUP, ATT_HEAD_DIM
    xp, xs = x_prompt, x_sample
    bp, dt = xp.shape[0], xp.dtype
    new_p, new_s = [], []
    for l in range(DEPTH):
        params = (norm1[l], w_in[l], conv_a_w[l], w_out[l], pool_w[l], pool_scale[l], norm2[l],
                  w_gate[l], w_up[l], ffn_conv_w[l], w_down[l])
        p_bufs = (jnp.zeros((bp, CONV_K - 1, CONV_WIDTH), dt),
                  tuple(jnp.zeros((bp, 0, 2, hh, dh), dt) for _ in DIL_GROUPS),
                  jnp.zeros((bp, POOL_BUF, POOL_WIDTH), dt),
                  jnp.zeros((bp, FFN_CONV_K - 1, D_FF), dt))
        xp, sp = decoder_layer(xp, p_bufs, params, slopes, 0)
        s_bufs = (state_conv_a[l], tuple(c[l] for c in kv_caches), state_pool[l], state_ffn_conv[l])
        xs, ss = decoder_layer(xs, s_bufs, params, slopes, PAST_LEN)
        new_p.append(sp)
        new_s.append(ss)

    def stk(lst, i):
        return jnp.stack([s[i] for s in lst])

    y_prompt = rms_norm(xp, final_norm)
    y_sample = rms_norm(xs, final_norm)
    return (y_prompt, y_sample,
            stk(new_p, 0), stk(new_s, 0), stk(new_p, 1), stk(new_s, 1), stk(new_p, 2), stk(new_s, 2),
            stk(new_p, 3), stk(new_s, 3), stk(new_p, 4), stk(new_s, 4), stk(new_p, 5), stk(new_s, 5))
```

```cpp
#include <hip/hip_runtime.h>
#include <hip/hip_cooperative_groups.h>
#include <cstdio>
#include <cstdint>
namespace pg8 {
#define PG8_LAS __attribute__((address_space(3)))
typedef unsigned short bf16_t;
typedef short bf16x8 __attribute__((ext_vector_type(8)));
typedef float f32x4 __attribute__((ext_vector_type(4)));
typedef unsigned u32x4 __attribute__((ext_vector_type(4)));
constexpr int BM = 256, BK = 64, HALF = 128, HTB = HALF * BK * 2  , STAGE_BYTES = 8 * HTB, NXCD = 8, WGM = 8;

__host__ __device__ __forceinline__ int lds_byte(int r, int c) { const int st = (r >> 4) * 2 + (c >> 5), rr = r & 15, cc = c & 31, ob = rr * 64 + cc * 2; return st * 1024 + (ob ^ (((ob >> 9) & 1) << 5)); }
__host__ __device__ __forceinline__ void stage_rc(int b, int& R, int& C) { const int st = b / 1024, sb = b % 1024, swz = sb ^ (((sb >> 9) & 1) << 5); R = (st >> 1) * 16 + swz / 64; C = (st & 1) * 32 + (swz % 64) / 2; }
__host__ __device__ __forceinline__ int perm32(int rho) { const int n = rho >> 4, i = rho & 15; return 8 * (i >> 2) + 4 * n + (i & 3); }

struct Unit { int pm, pn; };
struct Gemm { const bf16_t* A; const bf16_t* Bt; int M, N, K; };

struct StaticOrder {
    int nM, nN, nwg, G, c;
    __host__ __device__ void init(int M, int N, int G_, int c_) { nM = M / BM; nN = N / BM; nwg = nM * nN; G = G_; c = c_; }
    __host__ __device__ bool next(int i, Unit& u) const {
        const long L = (long)i * G + c; if (L >= nwg) return false;
        int wgid = (int)L; { const int q = nwg / NXCD, r = nwg % NXCD, xcd = wgid % NXCD, off = wgid / NXCD; wgid = (xcd < r ? xcd * (q + 1) : r * (q + 1) + (xcd - r) * q) + off; }
        const int nig = WGM * nN, gid = wgid / nig, fm = gid * WGM, gsz = (nM - fm) < WGM ? (nM - fm) : WGM;
        u.pm = fm + ((wgid % nig) % gsz); u.pn = (wgid % nig) / gsz; return true;
    }
    __device__ __forceinline__ void a_ready(const Unit&) const {}
    __device__ __forceinline__ void done(const Unit&) const {}
};
__device__ __forceinline__ unsigned cvt_pk_bf16(float lo, float hi) { unsigned r; asm volatile("v_cvt_pk_bf16_f32 %0, %1, %2" : "=v"(r) : "v"(lo), "v"(hi)); return r; }
struct EpiStoreBf16 {
    static constexpr bool PERM = true, AFTER_DRAIN = false;
    struct State { float s0, s1; };
    bf16_t* O; int ldc; const float* ss;
    __device__ __forceinline__ void pre(State& st, const Unit& u, int wr, int lane) const { const float* p = ss + u.pm * BM + wr * 64 + lane; st.s0 = p[0]; st.s1 = p[HALF]; }
    __device__ __forceinline__ void operator()(const f32x4 (&acc)[2][2][4][2], const Unit& u, int wr, int wc, int fr, int fq, const State& st) const {
        const int row0 = u.pm * BM + wr * 64 + fr, col0 = u.pn * BM + wc * 32 + 8 * fq;
        const float r0 = __builtin_amdgcn_rsqf(st.s0 * (1.0f / 2048.0f) + 1e-6f), r1 = __builtin_amdgcn_rsqf(st.s1 * (1.0f / 2048.0f) + 1e-6f);
#pragma unroll
        for (int ai = 0; ai < 2; ++ai)
#pragma unroll
            for (int m = 0; m < 4; ++m) { const int row = row0 + ai * HALF + m * 16; bf16_t* rowp = O + (size_t)row * ldc + col0;
                const float rs = __shfl(ai ? r1 : r0, m * 16 + fr);
#pragma unroll
                for (int bj = 0; bj < 2; ++bj) { const f32x4 v0 = acc[ai][bj][m][0] * rs, v1 = acc[ai][bj][m][1] * rs;
                    u32x4 w; w.x = cvt_pk_bf16(v0[0], v0[1]); w.y = cvt_pk_bf16(v0[2], v0[3]); w.z = cvt_pk_bf16(v1[0], v1[1]); w.w = cvt_pk_bf16(v1[2], v1[3]);
                    *(u32x4*)(rowp + bj * HALF) = w; } }
    }
};
struct EpiScaleBf16 {
    static constexpr bool PERM = true, AFTER_DRAIN = false;
    struct State {};
    bf16_t* O; int ldc; const float* scale;
    __device__ __forceinline__ void pre(State&, const Unit&, int, int) const {}
    __device__ __forceinline__ void operator()(const f32x4 (&acc)[2][2][4][2], const Unit& u, int wr, int wc, int fr, int fq, const State&) const {
        const int row0 = u.pm * BM + wr * 64 + fr, col0 = wc * 32 + 8 * fq;
#pragma unroll
        for (int ai = 0; ai < 2; ++ai)
#pragma unroll
            for (int m = 0; m < 4; ++m) { bf16_t* rowp = O + (size_t)(row0 + ai * HALF + m * 16) * ldc + col0;
#pragma unroll
                for (int bj = 0; bj < 2; ++bj) { const f32x4 v0 = acc[ai][bj][m][0] * *(const f32x4*)(scale + col0 + bj * HALF), v1 = acc[ai][bj][m][1] * *(const f32x4*)(scale + col0 + bj * HALF + 4);
                    u32x4 w; w.x = cvt_pk_bf16(v0[0], v0[1]); w.y = cvt_pk_bf16(v0[2], v0[3]); w.z = cvt_pk_bf16(v1[0], v1[1]); w.w = cvt_pk_bf16(v1[2], v1[3]);
                    *(u32x4*)(rowp + bj * HALF) = w; } }
    }
};
template <bool BASE_F32, bool OUT_F32> struct EpiRes {
    static constexpr bool PERM = true, AFTER_DRAIN = false;
    struct State {};
    const float* basef; const bf16_t* baseb; float* outf; bf16_t* xb; float* ss; int ldc;
    __device__ __forceinline__ void pre(State&, const Unit&, int, int) const {}
    __device__ __forceinline__ void ldbase(f32x4 (&b)[4], size_t off) const {
        if (BASE_F32) {
#pragma unroll
            for (int q = 0; q < 4; ++q) b[q] = *(const f32x4*)(basef + off + (q >> 1) * HALF + (q & 1) * 4);
        } else {
#pragma unroll
            for (int bj = 0; bj < 2; ++bj) { const u32x4 w = *(const u32x4*)(baseb + off + bj * HALF);
                b[bj * 2] = (f32x4){__builtin_bit_cast(float, w.x << 16), __builtin_bit_cast(float, w.x & 0xffff0000u), __builtin_bit_cast(float, w.y << 16), __builtin_bit_cast(float, w.y & 0xffff0000u)};
                b[bj * 2 + 1] = (f32x4){__builtin_bit_cast(float, w.z << 16), __builtin_bit_cast(float, w.z & 0xffff0000u), __builtin_bit_cast(float, w.w << 16), __builtin_bit_cast(float, w.w & 0xffff0000u)}; }
        }
    }
    __device__ __forceinline__ void operator()(const f32x4 (&acc)[2][2][4][2], const Unit& u, int wr, int wc, int fr, int fq, const State&) const {
        const int row0 = u.pm * BM + wr * 64 + fr, col0 = u.pn * BM + wc * 32 + 8 * fq;
        f32x4 bb[2][4];
        ldbase(bb[0], (size_t)row0 * ldc + col0);
#pragma unroll
        for (int it = 0; it < 8; ++it) { const int ai = it >> 2, m = it & 3; const int row = row0 + ai * HALF + m * 16; const size_t off = (size_t)row * ldc + col0; float sq = 0.f;
            if (it + 1 < 8) ldbase(bb[(it + 1) & 1], (size_t)(row0 + ((it + 1) >> 2) * HALF + ((it + 1) & 3) * 16) * ldc + col0);
            asm volatile("" ::: "memory");
#pragma unroll
            for (int bj = 0; bj < 2; ++bj) { const f32x4 v0 = bb[it & 1][bj * 2] + acc[ai][bj][m][0], v1 = bb[it & 1][bj * 2 + 1] + acc[ai][bj][m][1];
                if (OUT_F32) { *(f32x4*)(outf + off + bj * HALF) = v0; *(f32x4*)(outf + off + bj * HALF + 4) = v1; }
                else { u32x4 w; w.x = cvt_pk_bf16(v0[0], v0[1]); w.y = cvt_pk_bf16(v0[2], v0[3]); w.z = cvt_pk_bf16(v1[0], v1[1]); w.w = cvt_pk_bf16(v1[2], v1[3]);
                    *(u32x4*)(xb + off + bj * HALF) = w;
                    sq += (v0[0] * v0[0] + v0[1] * v0[1]) + (v0[2] * v0[2] + v0[3] * v0[3]) + (v1[0] * v1[0] + v1[1] * v1[1]) + (v1[2] * v1[2] + v1[3] * v1[3]); } }
            if (!OUT_F32) { sq += __shfl_xor(sq, 16); sq += __shfl_xor(sq, 32); if (fq == 0) unsafeAtomicAdd(ss + row, sq); }
        }
    }
};
__device__ __forceinline__ float dpp_ror1(float v) { return __builtin_bit_cast(float, __builtin_amdgcn_update_dpp(0, __builtin_bit_cast(int, v), 0x121, 0xf, 0xf, false)); }
__device__ __forceinline__ float dpp_ror2(float v) { return __builtin_bit_cast(float, __builtin_amdgcn_update_dpp(0, __builtin_bit_cast(int, v), 0x122, 0xf, 0xf, false)); }
struct EpiAct {
    static constexpr bool PERM = true, AFTER_DRAIN = false;
    struct State { float s0, s1; };
    bf16_t* GUo; int ldgu; bf16_t* Ab; int dff; const float* ss; const float* cw; float* halo; float* g01; float* u01; float* fstate; PG8_LAS float* lh;
    __device__ __forceinline__ void pre(State& st, const Unit& u, int wr, int lane) const { const float* p = ss + u.pm * BM + wr * 64 + lane; st.s0 = p[0]; st.s1 = p[HALF]; }
    __device__ __forceinline__ void operator()(const f32x4 (&acc)[2][2][4][2], const Unit& u, int wr, int wc, int fr, int fq, const State& st) const {
        const float r0 = __builtin_amdgcn_rsqf(st.s0 * (1.0f / 2048.0f) + 1e-6f), r1 = __builtin_amdgcn_rsqf(st.s1 * (1.0f / 2048.0f) + 1e-6f);
        if (u.pm >= 32) {
            const int row0 = u.pm * BM + wr * 64 + fr, col0 = u.pn * BM + wc * 32 + 8 * fq;
#pragma unroll
            for (int ai = 0; ai < 2; ++ai)
#pragma unroll
                for (int m = 0; m < 4; ++m) { bf16_t* rowp = GUo + (size_t)(row0 + ai * HALF + m * 16) * ldgu + col0; const float rs = __shfl(ai ? r1 : r0, m * 16 + fr);
#pragma unroll
                    for (int bj = 0; bj < 2; ++bj) { const f32x4 v0 = acc[ai][bj][m][0] * rs, v1 = acc[ai][bj][m][1] * rs;
                        u32x4 w; w.x = cvt_pk_bf16(v0[0], v0[1]); w.y = cvt_pk_bf16(v0[2], v0[3]); w.z = cvt_pk_bf16(v1[0], v1[1]); w.w = cvt_pk_bf16(v1[2], v1[3]);
                        *(u32x4*)(rowp + bj * HALF) = w; } }
            return;
        }
        const int cc = wc * 32 + 8 * fq, ch = u.pn * HALF + cc;
        f32x4 w0[2], w1[2], w2[2];
#pragma unroll
        for (int n = 0; n < 2; ++n) { w0[n] = *(const f32x4*)(cw + ch + 4 * n); w1[n] = *(const f32x4*)(cw + dff + ch + 4 * n); w2[n] = *(const f32x4*)(cw + 2 * dff + ch + 4 * n); }
#pragma unroll
        for (int ai = 0; ai < 2; ++ai) { const int bi = 2 * ai + wr; const float rs = __shfl(ai ? r1 : r0, 48 + fr);
            if (fr >= 14) {
#pragma unroll
                for (int n = 0; n < 2; ++n) { const f32x4 gv = acc[ai][0][3][n] * rs; *(PG8_LAS f32x4*)(lh + (bi * 2 + (fr - 14)) * HALF + cc + 4 * n) = gv;
                    if (bi == 3) { *(f32x4*)(halo + (size_t)(u.pm * 2 + (fr - 14)) * dff + ch + 4 * n) = gv;
                        if ((u.pm & 7) == 7) *(f32x4*)(fstate + (size_t)((u.pm >> 3) * 2 + (fr - 14)) * dff + ch + 4 * n) = gv; } }
            } }
        asm volatile("s_waitcnt lgkmcnt(0)" ::: "memory"); __builtin_amdgcn_s_barrier(); asm volatile("" ::: "memory");
#pragma unroll
        for (int ai = 0; ai < 2; ++ai) { const int bi = 2 * ai + wr;
            float p1c[8], p2c[8];
            { f32x4 hp[2];
#pragma unroll
              for (int n = 0; n < 2; ++n) hp[n] = bi > 0 ? *(const PG8_LAS f32x4*)(lh + ((bi - 1) * 2 + (fr & 1)) * HALF + cc + 4 * n) : (f32x4){0.f, 0.f, 0.f, 0.f};
#pragma unroll
              for (int i = 0; i < 8; ++i) { p1c[i] = dpp_ror1(hp[i >> 2][i & 3]); p2c[i] = dpp_ror2(hp[i >> 2][i & 3]); } }
#pragma unroll
            for (int m = 0; m < 4; ++m) { const float rs = __shfl(ai ? r1 : r0, m * 16 + fr); const int row = u.pm * BM + ai * HALF + wr * 64 + m * 16 + fr;
                float a8[8], g8[8], u8[8];
#pragma unroll
                for (int i = 0; i < 8; ++i) { const int n = i >> 2, e = i & 3;
                    const float cur = acc[ai][0][m][n][e] * rs, up = acc[ai][1][m][n][e] * rs;
                    const float c1 = dpp_ror1(cur), c2 = dpp_ror2(cur);
                    const float q1 = fr >= 1 ? c1 : p1c[i], q2 = fr >= 2 ? c2 : p2c[i];
                    const float gc = w0[n][e] * q2 + w1[n][e] * q1 + w2[n][e] * cur;
                    a8[i] = gc * __builtin_amdgcn_rcpf(1.0f + __expf(-gc)) * up;
                    g8[i] = cur; u8[i] = up; p1c[i] = c1; p2c[i] = c2; }
                if (bi == 0 && m == 0 && fr < 2) {
                    float* gp = g01 + (size_t)(u.pm * 2 + fr) * dff + ch; float* up_ = u01 + (size_t)(u.pm * 2 + fr) * dff + ch;
                    *(f32x4*)gp = (f32x4){g8[0], g8[1], g8[2], g8[3]}; *(f32x4*)(gp + 4) = (f32x4){g8[4], g8[5], g8[6], g8[7]};
                    *(f32x4*)up_ = (f32x4){u8[0], u8[1], u8[2], u8[3]}; *(f32x4*)(up_ + 4) = (f32x4){u8[4], u8[5], u8[6], u8[7]};
                } else { u32x4 w; w.x = cvt_pk_bf16(a8[0], a8[1]); w.y = cvt_pk_bf16(a8[2], a8[3]); w.z = cvt_pk_bf16(a8[4], a8[5]); w.w = cvt_pk_bf16(a8[6], a8[7]);
                    *(u32x4*)(Ab + (size_t)row * dff + ch) = w; }
            } }
    }
};
struct OneUnit {
    int pm; bool valid;
    __device__ __forceinline__ bool next(int i, Unit& u) const { if (i != 0 || !valid) return false; u.pm = pm; u.pn = 0; return true; }
    __device__ __forceinline__ void a_ready(const Unit&) const {}
    __device__ __forceinline__ void done(const Unit&) const {}
};
template <class Epi, class Sched, bool ALIGN_EPI = false, bool SP2 = false>
__device__ __forceinline__ void gemm_phase(PG8_LAS unsigned char* lds, const Gemm g, const Sched& S, const Epi& E, const int tid) {
    const int wid = __builtin_amdgcn_readfirstlane(tid >> 6), lane = tid & 63, wr = wid >> 2, wc = wid & 3, fr = lane & 15, fq = lane >> 4;
    const int K = g.K, nt = K / BK;
    unsigned voffA[2], voffB[2];
#pragma unroll
    for (int i = 0; i < 2; ++i) { int R, C; stage_rc(tid * 16 + i * 8192, R, C); const int Rb = Epi::PERM ? ((R & ~31) + perm32(R & 31)) : R;
        voffA[i] = (unsigned)(R * K + C) * 2u; voffB[i] = (unsigned)(Rb * K + C) * 2u; }
    const size_t kstep = (size_t)(BK * 2);
    const size_t hstep = (size_t)HALF * K * 2;
    const size_t tstep = 2 * hstep;
    const unsigned ldsw = (unsigned)wid * 1024u;
    const int aoff = lds_byte(wr * 64 + fr, fq * 8), boff = lds_byte(wc * 32 + fr, fq * 8);
#define PG8_SA(b, h) (((b) * 2 + (h)) * HTB)
#define PG8_SB(b, h) ((4 + (b) * 2 + (h)) * HTB)
#define PG8_STAGE(bufoff, gbase, voff) do { _Pragma("unroll") for (int _i = 0; _i < 2; ++_i) \
        __builtin_amdgcn_global_load_lds((const unsigned*)((const char*)(gbase) + (voff)[_i]), (PG8_LAS unsigned*)(lds + (bufoff) + ldsw + _i * 8192), 16, 0, 0); } while (0)
#define PG8_LDA(dst, b, h) do { _Pragma("unroll") for (int m = 0; m < 4; ++m) _Pragma("unroll") for (int k = 0; k < 2; ++k) dst[m][k] = *(const PG8_LAS bf16x8*)(lds + PG8_SA(b, h) + aoff + m * 2048 + k * 1024); } while (0)
#define PG8_LDB(dst, b, h) do { _Pragma("unroll") for (int n = 0; n < 2; ++n) _Pragma("unroll") for (int k = 0; k < 2; ++k) dst[n][k] = *(const PG8_LAS bf16x8*)(lds + PG8_SB(b, h) + boff + n * 2048 + k * 1024); } while (0)
#define PG8_MMA(ai, bj, At, Bt) do { __builtin_amdgcn_s_setprio(1); _Pragma("unroll") for (int m = 0; m < 4; ++m) _Pragma("unroll") for (int n = 0; n < 2; ++n) _Pragma("unroll") for (int k = 0; k < 2; ++k) \
        acc[ai][bj][m][n] = __builtin_amdgcn_mfma_f32_16x16x32_bf16(Bt[n][k], At[m][k], acc[ai][bj][m][n], 0, 0, 0); __builtin_amdgcn_s_setprio(0); } while (0)
#define PG8_WAIT_V(n) asm volatile("s_waitcnt vmcnt(" #n ")" ::: "memory")
#define PG8_WAIT_L(n) asm volatile("s_waitcnt lgkmcnt(" #n ")" ::: "memory")
#define PG8_BAR __builtin_amdgcn_s_barrier()
#define PG8_SCHED __builtin_amdgcn_sched_barrier(0)
    Unit cur, nxt; int ui = 0;
    if (!S.next(0, cur)) return;
    f32x4 acc[2][2][4][2];
#pragma unroll
    for (int a = 0; a < 2; ++a)
#pragma unroll
        for (int b = 0; b < 2; ++b)
#pragma unroll
            for (int m = 0; m < 4; ++m)
#pragma unroll
                for (int n = 0; n < 2; ++n) acc[a][b][m][n] = (f32x4){0.f, 0.f, 0.f, 0.f};
    bf16x8 At[4][2], B0[2][2], B1[2][2];
    typename Epi::State est;
    const char* cA = (const char*)g.A + (size_t)cur.pm * tstep; const char* cB = (const char*)g.Bt + (size_t)cur.pn * tstep;
    S.a_ready(cur);
    if constexpr (SP2) {
        PG8_STAGE(PG8_SB(0, 0), cB, voffB); PG8_STAGE(PG8_SB(0, 1), cB + hstep, voffB); PG8_STAGE(PG8_SA(0, 0), cA, voffA); PG8_STAGE(PG8_SA(0, 1), cA + hstep, voffA);
        if (wr == 1) PG8_BAR;
        PG8_WAIT_V(2); PG8_BAR;
        PG8_STAGE(PG8_SB(1, 0), cB + kstep, voffB); PG8_STAGE(PG8_SA(1, 0), cA + kstep, voffA); PG8_STAGE(PG8_SB(1, 1), cB + hstep + kstep, voffB);
        PG8_WAIT_V(6); PG8_BAR;
    } else {
        PG8_STAGE(PG8_SB(0, 0), cB, voffB); PG8_STAGE(PG8_SA(0, 0), cA, voffA); PG8_STAGE(PG8_SB(0, 1), cB + hstep, voffB); PG8_STAGE(PG8_SA(0, 1), cA + hstep, voffA);
        if (wr == 1) PG8_BAR;
        PG8_WAIT_V(4); PG8_BAR;
        PG8_STAGE(PG8_SB(1, 0), cB + kstep, voffB); PG8_STAGE(PG8_SA(1, 0), cA + kstep, voffA); PG8_STAGE(PG8_SB(1, 1), cB + hstep + kstep, voffB);
        PG8_WAIT_V(6); PG8_BAR;
    }
    for (;;) {
        const bool has_next = S.next(ui + 1, nxt);
        const char* nA = has_next ? (const char*)g.A + (size_t)nxt.pm * tstep : cA; const char* nB = has_next ? (const char*)g.Bt + (size_t)nxt.pn * tstep : cB;
        for (int t = 0; t < nt; t += 2) {
            const bool last = (t == nt - 2);
            const char* a1 = cA + (size_t)(t + 1) * kstep;
            const char* a2 = last ? nA : cA + (size_t)(t + 2) * kstep; const char* b2 = last ? nB : cB + (size_t)(t + 2) * kstep;
            const char* a3 = a2 + kstep; const char* b3 = b2 + kstep;
            if (last && has_next) S.a_ready(nxt);
            if (last) E.pre(est, cur, wr, lane);
            if constexpr (SP2) {
            PG8_LDB(B0, 0, 0); PG8_LDB(B1, 0, 1); PG8_SCHED; PG8_LDA(At, 0, 0); PG8_STAGE(PG8_SA(1, 1), a1 + hstep, voffA);
            PG8_WAIT_V(8); PG8_WAIT_L(0); PG8_BAR; PG8_MMA(0, 0, At, B0); PG8_MMA(0, 1, At, B1); PG8_BAR; PG8_SCHED;
            PG8_LDA(At, 0, 1); PG8_STAGE(PG8_SB(0, 0), b2, voffB); PG8_STAGE(PG8_SB(0, 1), b2 + hstep, voffB); PG8_STAGE(PG8_SA(0, 0), a2, voffA);
            PG8_WAIT_V(8); PG8_WAIT_L(0); PG8_BAR; PG8_MMA(1, 0, At, B0); PG8_MMA(1, 1, At, B1); PG8_BAR; PG8_SCHED;
            PG8_LDB(B0, 1, 0); PG8_LDB(B1, 1, 1); PG8_SCHED; PG8_LDA(At, 1, 0); PG8_STAGE(PG8_SA(0, 1), a2 + hstep, voffA);
            PG8_WAIT_V(8); PG8_WAIT_L(0); PG8_BAR; PG8_MMA(0, 0, At, B0); PG8_MMA(0, 1, At, B1); PG8_BAR; PG8_SCHED;
            PG8_LDA(At, 1, 1); PG8_STAGE(PG8_SB(1, 0), b3, voffB); PG8_STAGE(PG8_SB(1, 1), b3 + hstep, voffB); PG8_STAGE(PG8_SA(1, 0), a3, voffA);
            PG8_WAIT_V(8); PG8_WAIT_L(0); PG8_BAR; PG8_MMA(1, 0, At, B0); PG8_MMA(1, 1, At, B1); PG8_BAR; PG8_SCHED;
            } else {
            PG8_LDB(B0, 0, 0); PG8_SCHED; PG8_LDA(At, 0, 0); PG8_STAGE(PG8_SA(1, 1), a1 + hstep, voffA);
            PG8_WAIT_L(8); PG8_BAR; PG8_WAIT_L(0); PG8_MMA(0, 0, At, B0); PG8_BAR; PG8_SCHED;
            PG8_LDB(B1, 0, 1); PG8_STAGE(PG8_SB(0, 0), b2, voffB);
            PG8_BAR; PG8_WAIT_L(0); PG8_MMA(0, 1, At, B1); PG8_BAR;
            PG8_LDA(At, 0, 1); PG8_STAGE(PG8_SA(0, 0), a2, voffA);
            PG8_BAR; PG8_WAIT_L(0); PG8_MMA(1, 0, At, B0); PG8_BAR; PG8_SCHED;
            PG8_STAGE(PG8_SB(0, 1), b2 + hstep, voffB);
            PG8_WAIT_V(6); PG8_BAR; PG8_MMA(1, 1, At, B1); PG8_BAR;
            PG8_LDB(B0, 1, 0); PG8_SCHED; PG8_LDA(At, 1, 0); PG8_STAGE(PG8_SA(0, 1), a2 + hstep, voffA);
            PG8_WAIT_L(8); PG8_BAR; PG8_WAIT_L(0); PG8_MMA(0, 0, At, B0); PG8_BAR; PG8_SCHED;
            PG8_LDB(B1, 1, 1); PG8_STAGE(PG8_SB(1, 0), b3, voffB);
            PG8_BAR; PG8_WAIT_L(0); PG8_MMA(0, 1, At, B1); PG8_BAR;
            PG8_LDA(At, 1, 1); PG8_STAGE(PG8_SA(1, 0), a3, voffA);
            PG8_BAR; PG8_WAIT_L(0); PG8_MMA(1, 0, At, B0); PG8_BAR; PG8_SCHED;
            PG8_STAGE(PG8_SB(1, 1), b3 + hstep, voffB);
            PG8_WAIT_V(6); PG8_BAR; PG8_MMA(1, 1, At, B1); PG8_BAR;
            }
        }
        if constexpr (ALIGN_EPI) { if (wr == 0) PG8_BAR; }
        if constexpr (!Epi::AFTER_DRAIN) { E(acc, cur, wr, wc, fr, fq, est); S.done(cur); }
        if (!has_next) break;
#pragma unroll
        for (int a = 0; a < 2; ++a)
#pragma unroll
            for (int b = 0; b < 2; ++b)
#pragma unroll
                for (int m = 0; m < 4; ++m)
#pragma unroll
                    for (int n = 0; n < 2; ++n) acc[a][b][m][n] = (f32x4){0.f, 0.f, 0.f, 0.f};
        cur = nxt; cA = nA; cB = nB; ++ui;
        if constexpr (ALIGN_EPI) { if (wr == 1) PG8_BAR; }
    }
    PG8_WAIT_V(0);
    if constexpr (!ALIGN_EPI) { if (wr == 0) PG8_BAR; }
    PG8_BAR;
    if constexpr (Epi::AFTER_DRAIN) { E.fused(acc, cur, wr, wc, fr, fq, lds, wid, lane); S.done(cur); }
#undef PG8_SA
#undef PG8_SB
#undef PG8_STAGE
#undef PG8_LDA
#undef PG8_LDB
#undef PG8_MMA
#undef PG8_WAIT_V
#undef PG8_WAIT_L
#undef PG8_BAR
#undef PG8_SCHED
}
}


namespace cg = cooperative_groups;
#define LAS __attribute__((address_space(3)))
typedef unsigned short bf16;
typedef unsigned v4u __attribute__((ext_vector_type(4)));
typedef unsigned v2u __attribute__((ext_vector_type(2)));
typedef float f32x4 __attribute__((ext_vector_type(4)));
typedef float f32x2 __attribute__((ext_vector_type(2)));
typedef short bf16x8 __attribute__((ext_vector_type(8)));
typedef short bf16x4 __attribute__((ext_vector_type(4)));
#define LDS_WAIT() asm volatile("s_waitcnt lgkmcnt(0)" ::: "memory")

#ifndef W_IN_ALIGN
#define W_IN_ALIGN true
#endif
#ifndef MIX_DBL
#define MIX_DBL 0
#endif
#ifndef MK_PER_PHASE
#define MK_PER_PHASE 0
#endif

constexpr int NT = 512, NWAVES = 8;
constexpr int DM = 2048, NBATCH = 4, SEQ = 2048, DEPTH = 2, DB = 8, DSQ = 8, PAST = 16384;
constexpr int MP = NBATCH * SEQ, MS = DB * DSQ, MT = MP + MS, MPAD = 8448;
constexpr int INC = 7168, DFF = 5504, GUC = 2 * DFF;
constexpr int QKV0 = 1536, POOL0 = 6144;
constexpr float RMS_EPS = 1e-6f;
constexpr float LOG2E = 1.4426950408889634f, LN2 = 0.6931471805599453f;

constexpr size_t O_YP = 0, O_YS = O_YP + (size_t)MP * DM;
constexpr size_t O_KV128P = O_YS + (size_t)MS * DM,            O_KV128S = O_KV128P + (size_t)DEPTH * NBATCH * 128 * 1024;
constexpr size_t O_KV512P = O_KV128S + (size_t)DEPTH * DB * 128 * 1024,  O_KV512S = O_KV512P + (size_t)DEPTH * NBATCH * 512 * 1024;
constexpr size_t O_KV2048P = O_KV512S + (size_t)DEPTH * DB * 512 * 1024, O_KV2048S = O_KV2048P + (size_t)DEPTH * NBATCH * 2048 * 1024;
constexpr size_t O_CONVP = O_KV2048S + (size_t)DEPTH * DB * 2048 * 1024, O_CONVS = O_CONVP + (size_t)DEPTH * NBATCH * 2 * 512;
constexpr size_t O_POOLP = O_CONVS + (size_t)DEPTH * DB * 2 * 512,       O_POOLS = O_POOLP + (size_t)DEPTH * NBATCH * 15 * 1024;
constexpr size_t O_FFNP = O_POOLS + (size_t)DEPTH * DB * 15 * 1024,      O_FFNS = O_FFNP + (size_t)DEPTH * NBATCH * 2 * DFF;
constexpr size_t O_END = O_FFNS + (size_t)DEPTH * DB * 2 * DFF;
static_assert(O_END == 83625984, "output map");

constexpr size_t al256(size_t x) { return (x + 255) & ~(size_t)255; }
constexpr size_t W_IN_B = (size_t)INC * DM * 2, W_OUT_B = (size_t)DM * DM * 2, W_GU_B = (size_t)GUC * DM * 2, W_DN_B = (size_t)DM * DFF * 2, W_PL_B = (size_t)4 * 256 * 256 * 2;
constexpr size_t WL_IN = 0, WL_OUT = WL_IN + W_IN_B, WL_GU = WL_OUT + W_OUT_B, WL_DN = WL_GU + W_GU_B, WL_PL = WL_DN + W_DN_B, WL_SIZE = WL_PL + W_PL_B;
constexpr size_t WS_W = 1u << 20;
constexpr size_t CTL_ZERO_BYTES = 16384;
constexpr size_t WS_SS = 65536;
static_assert(WS_SS + (size_t)5 * MPAD * 4 <= WS_W, "ss map");
constexpr int MISC_OFF = 143360;
constexpr size_t WS_XRES = al256(WS_W + DEPTH * WL_SIZE);
constexpr size_t WS_HB = al256(WS_XRES + (size_t)MPAD * DM * 4);
constexpr size_t WS_ABUF = al256(WS_HB + (size_t)MPAD * DM * 2);
constexpr size_t WS_R1 = al256(WS_ABUF + (size_t)MPAD * DFF * 2);
constexpr size_t WS_PROJ = WS_R1;
constexpr size_t WS_YCAT = al256(WS_PROJ + (size_t)MPAD * INC * 2);
constexpr size_t WS_OPART = al256(WS_YCAT + (size_t)MPAD * DM * 2);
constexpr size_t WS_LSE = al256(WS_OPART + (size_t)3 * MPAD * 512 * 2);
constexpr size_t WS_DBUF = al256(WS_LSE + (size_t)3 * MPAD * 4 * 4);
constexpr size_t WS_R1END = al256(WS_DBUF + (size_t)4 * MPAD * 256 * 2);
constexpr size_t WS_GU = WS_R1;
constexpr size_t WS_GUEND = al256(WS_GU + (size_t)MPAD * GUC * 2);
constexpr size_t WS_FIX = WS_R1END > WS_GUEND ? WS_R1END : WS_GUEND;
constexpr size_t FIX_ONE = (size_t)32 * 2 * DFF * 4;
constexpr size_t WS_END = al256(WS_FIX + 3 * FIX_ONE);

constexpr int LDS_BYTES = 147456;
constexpr int VT_PITCH = 264;

struct Args { const float* in[20]; float* out; unsigned char* ws; int ph_lo, ph_hi; };
typedef const __attribute__((address_space(4))) Args* KArgs;

struct Frame {
    LAS unsigned char* lds;
    int tid, lane, wave, G, bid;
};

__device__ __forceinline__ unsigned f2bf(float f) { unsigned u = __builtin_bit_cast(unsigned, f); return (u + 0x7fffu + ((u >> 16) & 1u)) >> 16; }
__device__ __forceinline__ unsigned pk2(float lo, float hi) { return f2bf(lo) | (f2bf(hi) << 16); }
__device__ __forceinline__ float bflo(unsigned w) { return __builtin_bit_cast(float, w << 16); }
__device__ __forceinline__ float bfhi(unsigned w) { return __builtin_bit_cast(float, w & 0xffff0000u); }
__device__ __forceinline__ void unpack8(const v4u w, float (&f)[8]) { f[0] = bflo(w.x); f[1] = bfhi(w.x); f[2] = bflo(w.y); f[3] = bfhi(w.y); f[4] = bflo(w.z); f[5] = bfhi(w.z); f[6] = bflo(w.w); f[7] = bfhi(w.w); }
__device__ __forceinline__ v4u pack8(const float (&f)[8]) { v4u w; w.x = pk2(f[0], f[1]); w.y = pk2(f[2], f[3]); w.z = pk2(f[4], f[5]); w.w = pk2(f[6], f[7]); return w; }
__device__ __forceinline__ v4u ld16(const bf16* p) { return *(const v4u*)p; }
__device__ __forceinline__ void ld8f(const float* p, float (&f)[8]) { const f32x4 a = *(const f32x4*)p, b = *(const f32x4*)(p + 4); f[0] = a.x; f[1] = a.y; f[2] = a.z; f[3] = a.w; f[4] = b.x; f[5] = b.y; f[6] = b.z; f[7] = b.w; }
__device__ __forceinline__ void st8f(float* p, const float (&f)[8]) { *(f32x4*)p = (f32x4){f[0], f[1], f[2], f[3]}; *(f32x4*)(p + 4) = (f32x4){f[4], f[5], f[6], f[7]}; }
__device__ __forceinline__ float wave_sum(float v) {
#pragma unroll
    for (int o = 1; o < 64; o <<= 1) v += __shfl_xor(v, o);
    return v;
}
__device__ __forceinline__ float wave_max(float v) {
#pragma unroll
    for (int o = 1; o < 64; o <<= 1) v = fmaxf(v, __shfl_xor(v, o));
    return v;
}
__device__ __forceinline__ int win_of(int g) { return g == 0 ? 128 : (g == 1 ? 512 : 2048); }
__device__ __forceinline__ int dil_of(int g) { return g == 0 ? 1 : (g == 1 ? 4 : 16); }
__device__ __forceinline__ size_t okvp_of(int g) { return g == 0 ? O_KV128P : (g == 1 ? O_KV512P : O_KV2048P); }
__device__ __forceinline__ size_t okvs_of(int g) { return g == 0 ? O_KV128S : (g == 1 ? O_KV512S : O_KV2048S); }

__device__ __forceinline__ void transpose_item(const float* W, int K, int N, bf16* WT, int k0, int n0, int drow0, LAS float* scr, int lane, const float* gain = nullptr) {
    const int c = lane & 7;
    float gn[8];
    if (gain) ld8f(gain + k0 + 8 * c, gn);
    else {
#pragma unroll
        for (int e = 0; e < 8; ++e) gn[e] = 1.0f; }
    float wv[32];
#pragma unroll
    for (int i = 0; i < 32; ++i) { const int kk = 2 * i + (lane >> 5); wv[i] = __builtin_nontemporal_load(W + (size_t)(k0 + kk) * N + n0 + (lane & 31)); }
#pragma unroll
    for (int i = 0; i < 32; ++i) { const int kk = 2 * i + (lane >> 5); scr[kk * 33 + (lane & 31)] = wv[i]; }
    LDS_WAIT();
#pragma unroll
    for (int j = 0; j < 4; ++j) { const int n = (lane >> 3) + 8 * j; const LAS float* s = scr + (8 * c) * 33 + n;
        v4u o; o.x = pk2(s[0 * 33] * gn[0], s[1 * 33] * gn[1]); o.y = pk2(s[2 * 33] * gn[2], s[3 * 33] * gn[3]); o.z = pk2(s[4 * 33] * gn[4], s[5 * 33] * gn[5]); o.w = pk2(s[6 * 33] * gn[6], s[7 * 33] * gn[7]);
        *(v4u*)(WT + (size_t)(drow0 + n) * K + k0 + 8 * c) = o; }
    LDS_WAIT();
}
constexpr int N_UNITS_IN = (MPAD / 256) * (INC / 256), N_UNITS_GU = (MPAD / 256) * (GUC / 256);
__device__ __forceinline__ bool tailcopy_ok(int G) { return (N_UNITS_IN % G) != 0 && (N_UNITS_GU % G) != 0; }
constexpr int COPY_SPLIT = 358;
__device__ __forceinline__ void cache_copy(KArgs ka, const Frame& F, int w, int nw, int f_lo = 0, int f_hi = 1024) {
    constexpr size_t R0 = (size_t)(128 - 8) * 256, R1 = (size_t)(512 - 8) * 256, R2 = (size_t)(2048 - 8) * 256;
    constexpr size_t T0 = R0 * DEPTH * DB, T1 = R1 * DEPTH * DB, T2 = R2 * DEPTH * DB, N4 = T0 + T1 + T2;
    const size_t p_lo = N4 * (size_t)f_lo / 1024, p_n = N4 * (size_t)f_hi / 1024 - p_lo;
    const size_t lo = p_lo + p_n * (size_t)w / (size_t)nw, hi = p_lo + p_n * (size_t)(w + 1) / (size_t)nw;
    const f32x4* s0 = (const f32x4*)ka->in[2]; const f32x4* s1 = (const f32x4*)ka->in[3]; const f32x4* s2 = (const f32x4*)ka->in[4];
    float* outp = ka->out;
    for (size_t q0 = lo + F.tid; q0 < hi; q0 += 8 * NT) {
        f32x4 v[8]; f32x4* d[8];
#pragma unroll
        for (int u = 0; u < 8; ++u) { size_t q = q0 + (size_t)u * NT; if (q >= hi) q = lo;
            const f32x4* src; f32x4* dst; size_t run4, win4;
            if (q < T0) { src = s0; dst = (f32x4*)(outp + O_KV128S); run4 = R0; win4 = 128 * 256; }
            else if (q < T0 + T1) { q -= T0; src = s1; dst = (f32x4*)(outp + O_KV512S); run4 = R1; win4 = 512 * 256; }
            else { q -= T0 + T1; src = s2; dst = (f32x4*)(outp + O_KV2048S); run4 = R2; win4 = 2048 * 256; }
            const size_t lb = q / run4, rem = q - lb * run4, o = lb * win4 + rem;
            v[u] = __builtin_nontemporal_load(src + o + 2048); d[u] = dst + o; }
#pragma unroll
        for (int u = 0; u < 8; ++u) if (q0 + (size_t)u * NT < hi) __builtin_nontemporal_store(v[u], d[u]);
    }
}
__device__ __forceinline__ void convert_items(KArgs ka, const Frame& F, int l, int wv, int nwv) {
    LAS float* scr = (LAS float*)(F.lds + F.wave * 16384);
    constexpr int I_IN = (DM / 64) * (INC / 32), I_OUT = (DM / 64) * (DM / 32), I_G = (DM / 64) * (DFF / 32), I_D = (DFF / 64) * (DM / 32), I_P = 4 * 4 * 8;
    constexpr int I_LAYER = I_IN + I_OUT + 2 * I_G + I_D + I_P;
    unsigned char* wl = ka->ws + WS_W + (size_t)l * WL_SIZE;
    for (int it = wv; it < I_LAYER; it += nwv) {
        int r = it;
        if (r < I_IN) { const int nb = INC / 32, kb = r / nb, n0 = (r % nb) * 32; transpose_item(ka->in[9] + (size_t)l * DM * INC, DM, INC, (bf16*)(wl + WL_IN), kb * 64, n0, n0, scr, F.lane, ka->in[8] + (size_t)l * DM); continue; } r -= I_IN;
        if (r < I_OUT) { const int nb = DM / 32, kb = r / nb, n0 = (r % nb) * 32; transpose_item(ka->in[11] + (size_t)l * DM * DM, DM, DM, (bf16*)(wl + WL_OUT), kb * 64, n0, n0, scr, F.lane); continue; } r -= I_OUT;
        if (r < I_G) { const int nb = DFF / 32, kb = r / nb, n0 = (r % nb) * 32; transpose_item(ka->in[15] + (size_t)l * DM * DFF, DM, DFF, (bf16*)(wl + WL_GU), kb * 64, n0, (n0 >> 7) * 256 + (n0 & 127), scr, F.lane, ka->in[14] + (size_t)l * DM); continue; } r -= I_G;
        if (r < I_G) { const int nb = DFF / 32, kb = r / nb, n0 = (r % nb) * 32; transpose_item(ka->in[16] + (size_t)l * DM * DFF, DM, DFF, (bf16*)(wl + WL_GU), kb * 64, n0, (n0 >> 7) * 256 + 128 + (n0 & 127), scr, F.lane, ka->in[14] + (size_t)l * DM); continue; } r -= I_G;
        if (r < I_D) { const int nb = DM / 32, kb = r / nb, n0 = (r % nb) * 32; transpose_item(ka->in[18] + (size_t)l * DFF * DM, DFF, DM, (bf16*)(wl + WL_DN), kb * 64, n0, n0, scr, F.lane); continue; } r -= I_D;
        { const int g = r / 32, rr = r % 32, kb = rr / 8, n0 = (rr % 8) * 32; transpose_item(ka->in[12] + ((size_t)l * 4 + g) * 65536, 256, 256, (bf16*)(wl + WL_PL) + (size_t)g * 65536, kb * 64, n0, n0, scr, F.lane); }
    }
}
__device__ __forceinline__ void phase_prep(KArgs ka, const Frame& F) {
    const int gw = F.bid * NWAVES + F.wave, NGW = F.G * NWAVES;
    convert_items(ka, F, 0, gw, NGW);
    if (!tailcopy_ok(F.G)) { for (int l = 1; l < DEPTH; ++l) convert_items(ka, F, l, gw, NGW); }
    {
        bf16* xb = (bf16*)(ka->ws + WS_HB); float* ss = (float*)(ka->ws + WS_SS);
        for (int r = gw; r < MT; r += NGW) {
            const f32x4* xr = (const f32x4*)(r < MP ? ka->in[0] + (size_t)r * DM : ka->in[1] + (size_t)(r - MP) * DM) + F.lane;
            f32x4 v[8]; float sq = 0.f;
#pragma unroll
            for (int j = 0; j < 8; ++j) { v[j] = xr[64 * j]; sq += (v[j].x * v[j].x + v[j].y * v[j].y) + (v[j].z * v[j].z + v[j].w * v[j].w); }
            sq = wave_sum(sq);
            v2u* o = (v2u*)(xb + (size_t)r * DM) + F.lane;
#pragma unroll
            for (int j = 0; j < 8; ++j) { v2u w; w.x = pk2(v[j].x, v[j].y); w.y = pk2(v[j].z, v[j].w); o[64 * j] = w; }
            if (F.lane == 0) ss[r] = sq;
        }
        for (int i = F.bid * NT + F.tid; i < 4 * MPAD; i += F.G * NT) ss[MPAD + i] = 0.f;
        for (int i = F.bid * NT + F.tid; i < MPAD - MT; i += F.G * NT) ss[MT + i] = 0.f;
    }
    if (!tailcopy_ok(F.G)) cache_copy(ka, F, F.bid, F.G);
}

template <bool F32OUT>
__device__ __forceinline__ void phase_norm(const Frame& F, const float* srcp, const float* srcs, const float* gain, bf16* dstb, float* dstp, float* dsts) {
    const int gw = F.bid * NWAVES + F.wave, NGW = F.G * NWAVES;
    f32x4 gv[8];
#pragma unroll
    for (int j = 0; j < 8; ++j) gv[j] = ((const f32x4*)gain)[F.lane + 64 * j];
    for (int r = gw; r < MT; r += NGW) {
        const float* xrow = r < MP ? srcp + (size_t)r * DM : srcs + (size_t)(r - MP) * DM;
        const f32x4* xr = (const f32x4*)xrow + F.lane;
        f32x4 v[8]; float s = 0.f;
#pragma unroll
        for (int j = 0; j < 8; ++j) { v[j] = xr[64 * j]; s += (v[j].x * v[j].x + v[j].y * v[j].y) + (v[j].z * v[j].z + v[j].w * v[j].w); }
        const float rstd = 1.0f / sqrtf(wave_sum(s) * (1.0f / DM) + RMS_EPS);
        if (F32OUT) {
            f32x4* o = (f32x4*)(r < MP ? dstp + (size_t)r * DM : dsts + (size_t)(r - MP) * DM) + F.lane;
#pragma unroll
            for (int j = 0; j < 8; ++j) o[64 * j] = v[j] * rstd * gv[j];
        } else {
            v2u* o = (v2u*)(dstb + (size_t)r * DM) + F.lane;
#pragma unroll
            for (int j = 0; j < 8; ++j) { const f32x4 y = v[j] * rstd * gv[j]; v2u w; w.x = pk2(y.x, y.y); w.y = pk2(y.z, y.w); o[64 * j] = w; }
        }
    }
}

__device__ __forceinline__ void phase_final(const Frame& F, const bf16* xb, const float* ss, const float* gain, float* dstp, float* dsts) {
    const int gw = F.bid * NWAVES + F.wave, NGW = F.G * NWAVES;
    float gn[4][8];
#pragma unroll
    for (int j = 0; j < 4; ++j) ld8f(gain + (j * 64 + F.lane) * 8, gn[j]);
    for (int r = gw; r < MT; r += NGW) {
        const float rstd = 1.0f / sqrtf(ss[r] * (1.0f / DM) + RMS_EPS);
        v4u xv[4];
#pragma unroll
        for (int j = 0; j < 4; ++j) xv[j] = ld16(xb + (size_t)r * DM + (j * 64 + F.lane) * 8);
        float* o = (r < MP ? dstp + (size_t)r * DM : dsts + (size_t)(r - MP) * DM);
#pragma unroll
        for (int j = 0; j < 4; ++j) { float x8[8]; unpack8(xv[j], x8);
#pragma unroll
            for (int e = 0; e < 8; ++e) x8[e] = x8[e] * rstd * gn[j][e];
            st8f(o + (j * 64 + F.lane) * 8, x8); }
    }
}

struct AttItem { int g, dil, rowbase, qcol, k_lo, it, h; };
__device__ __forceinline__ AttItem att_decode(int item) {
    AttItem a; a.g = item >> 8; const int rem = item & 255, b = rem >> 6, sub = rem & 15; a.h = (rem >> 4) & 3;
    a.dil = dil_of(a.g);
    const int r = a.g == 0 ? 0 : (a.g == 1 ? (sub >> 2) : sub); a.it = a.g == 0 ? sub : (a.g == 1 ? (sub & 3) : 0);
    a.rowbase = b * SEQ + r; a.qcol = QKV0 + a.g * 1536 + a.h * 128; a.k_lo = a.it * 128 - 128;
    return a;
}
constexpr int KL_PITCH = 136;
constexpr int KL_OFF = 128 * VT_PITCH * 2;
static_assert(KL_OFF + 256 * KL_PITCH * 2 <= MISC_OFF, "attention LDS images");
__device__ __forceinline__ void att_kvload(const Frame& F, const bf16* proj, const AttItem& a, v4u (&vv)[8], v4u (&kv)[8]) {
    const int kk = F.tid & 255, half = F.tid >> 8, kidx = a.k_lo + kk;
    const bf16* krow = proj + (size_t)(a.rowbase + (kidx >= 0 ? kidx : 0) * a.dil) * INC + a.qcol + 512 + half * 64;
#pragma unroll
    for (int i = 0; i < 8; ++i) kv[i] = ld16(krow + i * 8);
#pragma unroll
    for (int i = 0; i < 8; ++i) vv[i] = ld16(krow + 512 + i * 8);
}
__device__ __forceinline__ void attn_prompt_items(const Frame& F, const bf16* proj, bf16* opart, float* lse) {
    LAS bf16* Vt = (LAS bf16*)F.lds;
    LAS bf16* Kl = (LAS bf16*)(F.lds + KL_OFF);
    const int fr = F.lane & 15, fq = F.lane >> 4;
    int item = F.bid;
    if (item >= 768) return;
    AttItem a = att_decode(item);
    v4u vv[8], kv[8];
    att_kvload(F, proj, a, vv, kv);
    for (;;) {
        const int dil = a.dil, rowbase = a.rowbase, qcol = a.qcol, k_lo = a.k_lo, g = a.g, h = a.h;
        const int q0 = a.it * 128 + 16 * F.wave;
        const float slope = exp2f(-8.0f * (float)(g * 4 + h + 1) / 12.0f);
        const float c1 = 0.08838834764831845f * LOG2E, c2 = slope * (float)dil * LOG2E;
        int dl[4]; float lb[4];
#pragma unroll
        for (int j = 0; j < 4; ++j) { dl[j] = fr - fq * 4 - j; lb[j] = c2 * (float)dl[j]; }
        bf16x8 qf[4];
        { const bf16* qrow = proj + (size_t)(rowbase + (q0 + fr) * dil) * INC + qcol + fq * 8;
#pragma unroll
          for (int ks = 0; ks < 4; ++ks) qf[ks] = *(const bf16x8*)(qrow + ks * 32); }
        {
            const int kk = F.tid & 255, half = F.tid >> 8;
#pragma unroll
            for (int i = 0; i < 8; ++i) *(LAS v4u*)(Kl + (size_t)kk * KL_PITCH + half * 64 + i * 8) = kv[i];
#pragma unroll
            for (int i = 0; i < 8; ++i) { LAS bf16* dst = Vt + (size_t)((half * 8 + i) * 8) * VT_PITCH + kk;
                dst[0 * VT_PITCH] = (bf16)(vv[i].x & 0xffff); dst[1 * VT_PITCH] = (bf16)(vv[i].x >> 16); dst[2 * VT_PITCH] = (bf16)(vv[i].y & 0xffff); dst[3 * VT_PITCH] = (bf16)(vv[i].y >> 16);
                dst[4 * VT_PITCH] = (bf16)(vv[i].z & 0xffff); dst[5 * VT_PITCH] = (bf16)(vv[i].z >> 16); dst[6 * VT_PITCH] = (bf16)(vv[i].w & 0xffff); dst[7 * VT_PITCH] = (bf16)(vv[i].w >> 16); }
        }
        __syncthreads();
        const int nitem = item + F.G; const bool has_next = nitem < 768;
        AttItem an = a;
        if (has_next) { an = att_decode(nitem); att_kvload(F, proj, an, vv, kv); }
        f32x4 st[9];
#pragma unroll
        for (int jt = 0; jt < 9; ++jt) { const int kbase = q0 - 128 + 16 * jt;
            if (kbase >= 0) {
                const LAS bf16* kp = Kl + (size_t)(kbase - k_lo + fr) * KL_PITCH + fq * 8;
                f32x4 acc = (f32x4){0.f, 0.f, 0.f, 0.f};
#pragma unroll
                for (int ks = 0; ks < 4; ++ks) { const bf16x8 kf = *(const LAS bf16x8*)(kp + ks * 32); acc = __builtin_amdgcn_mfma_f32_16x16x32_bf16(kf, qf[ks], acc, 0, 0, 0); }
#pragma unroll
                for (int j = 0; j < 4; ++j) { const float s2 = acc[j] * c1 - (lb[j] + c2 * (float)(128 - 16 * jt));
                    st[jt][j] = ((jt > 0 || dl[j] <= 0) && (jt < 8 || dl[j] >= 0)) ? s2 : -INFINITY; }
            } else st[jt] = (f32x4){-INFINITY, -INFINITY, -INFINITY, -INFINITY};
        }
        float m = -INFINITY;
#pragma unroll
        for (int jt = 0; jt < 9; ++jt) m = fmaxf(fmaxf(fmaxf(st[jt][0], st[jt][1]), fmaxf(st[jt][2], st[jt][3])), m);
        m = fmaxf(m, __shfl_xor(m, 16)); m = fmaxf(m, __shfl_xor(m, 32));
        float lsum = 0.f;
#pragma unroll
        for (int jt = 0; jt < 9; ++jt)
#pragma unroll
            for (int j = 0; j < 4; ++j) { const float p = __builtin_amdgcn_exp2f(st[jt][j] - m); st[jt][j] = p; lsum += p; }
        lsum += __shfl_xor(lsum, 16); lsum += __shfl_xor(lsum, 32);
        f32x4 o[8];
#pragma unroll
        for (int dt = 0; dt < 8; ++dt) o[dt] = (f32x4){0.f, 0.f, 0.f, 0.f};
#pragma unroll
        for (int jt = 0; jt < 9; ++jt) {
            const int kbase = q0 - 128 + 16 * jt;
            if (kbase >= 0) {
                v2u pw; pw.x = pk2(st[jt][0], st[jt][1]); pw.y = pk2(st[jt][2], st[jt][3]);
                const bf16x4 pb = __builtin_bit_cast(bf16x4, pw);
                const LAS bf16* vp = Vt + (size_t)fr * VT_PITCH + (kbase - k_lo) + fq * 4;
#pragma unroll
                for (int dt = 0; dt < 8; ++dt) { const bf16x4 vf = *(const LAS bf16x4*)(vp + (size_t)dt * 16 * VT_PITCH); o[dt] = __builtin_amdgcn_mfma_f32_16x16x16bf16_1k(vf, pb, o[dt], 0, 0, 0); }
            }
        }
        const float inv = 1.0f / lsum;
        const size_t orow = (size_t)(rowbase + (q0 + fr) * dil);
        bf16* op = opart + ((size_t)g * MPAD + orow) * 512 + h * 128 + fq * 4;
#pragma unroll
        for (int dt = 0; dt < 8; ++dt) { v2u w; w.x = pk2(o[dt][0] * inv, o[dt][1] * inv); w.y = pk2(o[dt][2] * inv, o[dt][3] * inv); *(v2u*)(op + dt * 16) = w; }
        if (fq == 0) lse[((size_t)g * MPAD + orow) * 4 + h] = (m + log2f(lsum)) * LN2;
        __syncthreads();
        if (!has_next) break;
        item = nitem; a = an;
    }
}

__device__ __forceinline__ void attn_sample_item(KArgs ka, const Frame& F, int l, const bf16* proj, bf16* opart, float* lse, int item) {
    const int g = item >> 8, rem = item & 255, b = rem >> 5, t = (rem >> 2) & 7, h = rem & 3;
    const int win = win_of(g), dil = dil_of(g);
    const int row = MP + b * DSQ + t;
    const int qcol = QKV0 + g * 1536 + h * 128, kcol = qcol + 512, vcol = qcol + 1024;
    const float* cache = ka->in[2 + g] + ((size_t)(l * DB + b) * win) * 1024;
    LAS float* sc = (LAS float*)(F.lds + 135168 + F.wave * 1024);
    const float slope = exp2f(-8.0f * (float)(g * 4 + h + 1) / 12.0f);
    const float c1 = 0.08838834764831845f * LOG2E, c2 = slope * (float)dil * LOG2E;
    const int sub = F.lane >> 4, li = F.lane & 15;
    const int nnew = t / dil + 1;
    float q8[8]; { float t8[8]; unpack8(ld16(proj + (size_t)row * INC + qcol + li * 8), t8);
#pragma unroll
        for (int e = 0; e < 8; ++e) q8[e] = t8[e] * c1; }
#pragma unroll 1
    for (int j0 = 0; j0 < nnew; j0 += 4) {
        const int j = j0 + sub; float dot = 0.f;
        if (j < nnew) { float k8[8]; unpack8(ld16(proj + (size_t)(row - j * dil) * INC + kcol + li * 8), k8);
#pragma unroll
            for (int e = 0; e < 8; ++e) dot += q8[e] * k8[e]; }
        dot += __shfl_xor(dot, 1); dot += __shfl_xor(dot, 2); dot += __shfl_xor(dot, 4); dot += __shfl_xor(dot, 8);
        if (li == 0 && j < nnew) sc[j] = dot - c2 * (float)j;
    }
    { const float* kb = cache + h * 128 + li * 8;
#pragma unroll 1
      for (int jb = nnew; jb <= 128; jb += 32) {
        float k8[8][8];
#pragma unroll
        for (int i = 0; i < 8; ++i) { const int j = jb + 4 * i + sub; const int jc = j <= 128 ? j : 128; ld8f(kb + (size_t)(win + t - jc * dil) * 1024, k8[i]); }
#pragma unroll
        for (int i = 0; i < 8; ++i) { const int j = jb + 4 * i + sub; float dot = 0.f;
#pragma unroll
            for (int e = 0; e < 8; ++e) dot += q8[e] * k8[i][e];
            dot += __shfl_xor(dot, 1); dot += __shfl_xor(dot, 2); dot += __shfl_xor(dot, 4); dot += __shfl_xor(dot, 8);
            if (li == 0 && j <= 128) sc[j] = dot - c2 * (float)j; }
      } }
    LDS_WAIT();
    float s0 = sc[F.lane], s1 = sc[F.lane + 64], s2 = F.lane == 0 ? sc[128] : -INFINITY;
    const float m = wave_max(fmaxf(fmaxf(s0, s1), s2));
    s0 = exp2f(s0 - m); s1 = exp2f(s1 - m); s2 = F.lane == 0 ? exp2f(s2 - m) : 0.f;
    const float lsum = wave_sum(s0 + s1 + s2);
    sc[F.lane] = s0; sc[F.lane + 64] = s1; if (F.lane == 0) sc[128] = s2;
    LDS_WAIT();
    const int hf = F.lane >> 5, l32 = F.lane & 31;
    f32x4 o = (f32x4){0.f, 0.f, 0.f, 0.f};
#pragma unroll 1
    for (int j = hf; j < nnew; j += 2) { const float p = sc[j]; const v2u w = *(const v2u*)(proj + (size_t)(row - j * dil) * INC + vcol + l32 * 4);
        o += (f32x4){bflo(w.x), bfhi(w.x), bflo(w.y), bfhi(w.y)} * p; }
    { const float* vb = cache + 512 + h * 128 + l32 * 4;
#pragma unroll 1
      for (int jb = nnew; jb <= 128; jb += 32) {
        f32x4 vv[16];
#pragma unroll
        for (int i = 0; i < 16; ++i) { const int j = jb + 2 * i + hf; const int jc = j <= 128 ? j : 128; vv[i] = *(const f32x4*)(vb + (size_t)(win + t - jc * dil) * 1024); }
#pragma unroll
        for (int i = 0; i < 16; ++i) { const int j = jb + 2 * i + hf; const float p = j <= 128 ? sc[j <= 128 ? j : 128] : 0.f; o += vv[i] * p; }
      } }
    o.x += __shfl_xor(o.x, 32); o.y += __shfl_xor(o.y, 32); o.z += __shfl_xor(o.z, 32); o.w += __shfl_xor(o.w, 32);
    const float inv = 1.0f / lsum;
    if (hf == 0) { v2u w; w.x = pk2(o.x * inv, o.y * inv); w.y = pk2(o.z * inv, o.w * inv); *(v2u*)(opart + ((size_t)g * MPAD + row) * 512 + h * 128 + l32 * 4) = w; }
    if (F.lane == 0) lse[((size_t)g * MPAD + row) * 4 + h] = (m + log2f(lsum)) * LN2;
    LDS_WAIT();
}

__device__ __forceinline__ void phase_mixers(KArgs ka, const Frame& F, int l) {
    const bf16* proj = (const bf16*)(ka->ws + WS_PROJ); bf16* ycat = (bf16*)(ka->ws + WS_YCAT);
    bf16* opart = (bf16*)(ka->ws + WS_OPART); float* lse = (float*)(ka->ws + WS_LSE); bf16* dbuf = (bf16*)(ka->ws + WS_DBUF);
    float* outp = ka->out;
    asm volatile("" : "+v"(proj), "+v"(ycat), "+v"(opart), "+v"(lse), "+v"(dbuf), "+v"(outp));
    for (int rep = 0; rep < (MIX_DBL == 1 ? 2 : 1); ++rep) attn_prompt_items(F, proj, opart, lse);
    { const int gw = F.bid * NWAVES + F.wave, NGW = F.G * NWAVES;
      for (int rep = 0; rep < (MIX_DBL == 2 ? 2 : 1); ++rep)
      for (int item = gw; item < 768; item += NGW) attn_sample_item(ka, F, l, proj, opart, lse, item); }
    const int gt = F.bid * NT + F.tid, NGT = F.G * NT;
    { const float* cw = ka->in[10] + (size_t)l * 3 * 512; const float* cst = ka->in[5] + (size_t)l * DB * 2 * 512;
      for (int rep = 0; rep < (MIX_DBL == 3 ? 2 : 1); ++rep)
      for (int q = gt; q < (MT / 4) * 64; q += NGT) {
        const int r0 = (q >> 6) * 4, c = (q & 63) * 8; const bool smp = r0 >= MP;
        const int b = smp ? (r0 - MP) >> 3 : r0 >> 11, t0 = smp ? (r0 - MP) & 7 : r0 & 2047, T = smp ? DSQ : SEQ;
        const bf16* pr = proj + (size_t)r0 * INC + c;
        v4u xa[6], gc[6], gb[4];
#pragma unroll
        for (int i = 0; i < 6; ++i) { const bool ok = t0 + i - 2 >= 0; const bf16* p = pr + (ptrdiff_t)(ok ? i - 2 : 0) * INC; xa[i] = ld16(p); gc[i] = ld16(p + 1024); }
#pragma unroll
        for (int i = 0; i < 4; ++i) gb[i] = ld16(pr + (size_t)i * INC + 512);
        float w0[8], w1[8], w2[8]; ld8f(cw + c, w0); ld8f(cw + 512 + c, w1); ld8f(cw + 1024 + c, w2);
        float p[6][8];
#pragma unroll
        for (int i = 0; i < 6; ++i) { float a8[8], g8[8]; unpack8(xa[i], a8); unpack8(gc[i], g8);
#pragma unroll
            for (int e = 0; e < 8; ++e) p[i][e] = a8[e] * g8[e]; }
        if (t0 == 0) {
            if (smp) { ld8f(cst + ((size_t)b * 2 + 0) * 512 + c, p[0]); ld8f(cst + ((size_t)b * 2 + 1) * 512 + c, p[1]); }
            else {
#pragma unroll
                for (int e = 0; e < 8; ++e) { p[0][e] = 0.f; p[1][e] = 0.f; } }
        }
#pragma unroll
        for (int i = 0; i < 4; ++i) { float g8[8], y[8]; unpack8(gb[i], g8);
#pragma unroll
            for (int e = 0; e < 8; ++e) y[e] = g8[e] * (w0[e] * p[i][e] + w1[e] * p[i + 1][e] + w2[e] * p[i + 2][e]);
            *(v4u*)(ycat + (size_t)(r0 + i) * DM + c) = pack8(y); }
        if (t0 == T - 4) { float* so = outp + (smp ? O_CONVS + (((size_t)l * DB + b) * 2) * 512 : O_CONVP + (((size_t)l * NBATCH + b) * 2) * 512) + c; st8f(so, p[4]); st8f(so + 512, p[5]); }
      } }
    { const float* pst = ka->in[6] + (size_t)l * DB * 15 * 1024;
      for (int rep = 0; rep < (MIX_DBL == 4 ? 2 : 1); ++rep)
      for (int q = gt; q < (MT / 8) * 128; q += NGT) {
        const int r0 = (q >> 7) * 8, c = (q & 127) * 8; const bool smp = r0 >= MP;
        const int b = smp ? (r0 - MP) >> 3 : r0 >> 11, t0 = smp ? 0 : r0 & 2047;
        const int gi = c >> 8;
        const bf16* pr = proj + (size_t)r0 * INC + POOL0 + c;
        bf16* dp = dbuf + ((size_t)gi * MPAD + r0) * 256 + (c & 255);
#define POOL_ITEM(W) { v4u xr[W + 7]; \
        _Pragma("unroll") for (int i = 0; i < W + 7; ++i) { const int rel = i - (W - 1); \
            if (rel >= 0 || (!smp && t0 + rel >= 0)) xr[i] = ld16(pr + (ptrdiff_t)rel * INC); \
            else if (smp) { float f8[8]; ld8f(pst + ((size_t)b * 15 + 15 + rel) * 1024 + c, f8); xr[i] = pack8(f8); } \
            else xr[i] = (v4u){0u, 0u, 0u, 0u}; } \
        float sm[8]; _Pragma("unroll") for (int e = 0; e < 8; ++e) sm[e] = 0.f; \
        _Pragma("unroll") for (int i = 0; i < W - 1; ++i) { float f8[8]; unpack8(xr[i], f8); _Pragma("unroll") for (int e = 0; e < 8; ++e) sm[e] += f8[e]; } \
        _Pragma("unroll") for (int i = 0; i < 8; ++i) { float u8[8], d8[8]; unpack8(xr[i + W - 1], u8); _Pragma("unroll") for (int e = 0; e < 8; ++e) sm[e] += u8[e]; \
            const float rcnt = 1.0f / (float)(smp ? W : min(W, t0 + i + 1)); \
            _Pragma("unroll") for (int e = 0; e < 8; ++e) d8[e] = sm[e] * rcnt - u8[e]; \
            *(v4u*)(dp + (size_t)i * 256) = pack8(d8); \
            if (smp) st8f(outp + O_POOLS + (((size_t)l * DB + b) * 15 + i + 7) * 1024 + c, u8); \
            else if (t0 + i >= SEQ - 15) st8f(outp + O_POOLP + (((size_t)l * NBATCH + b) * 15 + (t0 + i - (SEQ - 15))) * 1024 + c, u8); \
            float o8[8]; unpack8(xr[i], o8); _Pragma("unroll") for (int e = 0; e < 8; ++e) sm[e] -= o8[e]; } }
        if (gi == 0) POOL_ITEM(2) else if (gi == 1) POOL_ITEM(4) else if (gi == 2) POOL_ITEM(8) else POOL_ITEM(16)
#undef POOL_ITEM
        if (smp) {
#pragma unroll
            for (int j = 0; j < 7; ++j) { float x[8]; ld8f(pst + ((size_t)b * 15 + 8 + j) * 1024 + c, x); st8f(outp + O_POOLS + (((size_t)l * DB + b) * 15 + j) * 1024 + c, x); } }
      } }
    const int nsw = (768 + NWAVES - 1) / NWAVES;
    const bool split = F.G >= 2 * nsw;
    const int gt5 = split ? (F.bid - nsw) * NT + F.tid : gt, NGT5 = split ? (F.G - nsw) * NT : NGT;
    if (!split || F.bid >= nsw)
#pragma unroll 1
    for (int g = 0; g < 3; ++g) {
        const int win = win_of(g); const int kvc = QKV0 + g * 1536 + 512;
        const int ntot = (NBATCH * win + MS) * 128;
        for (int rep = 0; rep < (MIX_DBL == 5 ? 2 : 1); ++rep)
        for (int q0 = gt5; q0 < ntot; q0 += 4 * NGT5) {
            v4u x[4]; float* dst[4];
#pragma unroll
            for (int u = 0; u < 4; ++u) { const int q = q0 + u * NGT5; const int qq = q < ntot ? q : 0; const int rr = qq >> 7, c = (qq & 127) * 8; int srow;
                if (rr < NBATCH * win) { const int b = rr / win, i = rr - b * win; srow = b * SEQ + SEQ - win + i; dst[u] = outp + okvp_of(g) + (((size_t)l * NBATCH + b) * win + i) * 1024 + c; }
                else { const int rs = rr - NBATCH * win, b = rs >> 3, i = rs & 7; srow = MP + rs; dst[u] = outp + okvs_of(g) + (((size_t)l * DB + b) * win + win - 8 + i) * 1024 + c; }
                x[u] = ld16(proj + (size_t)srow * INC + kvc + c); }
#pragma unroll
            for (int u = 0; u < 4; ++u) if (q0 + u * NGT5 < ntot) { float f8[8]; unpack8(x[u], f8); st8f(dst[u], f8); }
        }
    }
}

__device__ __forceinline__ void phase_merge(KArgs ka, const Frame& F) {
    const bf16* opart = (const bf16*)(ka->ws + WS_OPART); const float* lse = (const float*)(ka->ws + WS_LSE); bf16* ycat = (bf16*)(ka->ws + WS_YCAT);
    constexpr int NMRG = MT * 64, NPOOLWG = 4 * 33;
    const bool uneven = F.G > NPOOLWG + 32;
    const int CUT = uneven ? (int)((long long)NMRG * (F.G * 14) / (F.G * 14 + (F.G - NPOOLWG) * 12)) : NMRG;
    for (int pass = 0; pass < 2; ++pass) {
    if (pass == 1 && (!uneven || F.bid < NPOOLWG)) break;
    const int gt = pass == 0 ? F.bid * NT + F.tid : CUT + (F.bid - NPOOLWG) * NT + F.tid, NGT = pass == 0 ? F.G * NT : (F.G - NPOOLWG) * NT, qend = pass == 0 ? CUT : NMRG;
    for (int q = gt; q < qend; q += NGT) {
        const int r = q >> 6, c = (q & 63) * 8, h = c >> 7;
        const float l0 = lse[((size_t)0 * MPAD + r) * 4 + h], l1 = lse[((size_t)1 * MPAD + r) * 4 + h], l2 = lse[((size_t)2 * MPAD + r) * 4 + h];
        const float mx = fmaxf(l0, fmaxf(l1, l2));
        float e0 = __expf(l0 - mx), e1 = __expf(l1 - mx), e2 = __expf(l2 - mx); const float inv = 1.0f / (e0 + e1 + e2); e0 *= inv; e1 *= inv; e2 *= inv;
        float x0[8], x1[8], x2[8], y[8];
        unpack8(ld16(opart + ((size_t)0 * MPAD + r) * 512 + c), x0); unpack8(ld16(opart + ((size_t)1 * MPAD + r) * 512 + c), x1); unpack8(ld16(opart + ((size_t)2 * MPAD + r) * 512 + c), x2);
#pragma unroll
        for (int e = 0; e < 8; ++e) y[e] = e0 * x0[e] + e1 * x1[e] + e2 * x2[e];
        *(v4u*)(ycat + (size_t)r * DM + 512 + c) = pack8(y);
    }
    }
}

template <bool BASE_F32, bool OUT_F32> __device__ __forceinline__ void skinny_tile(const Frame& F, const bf16* A, const bf16* Bt, int K, const float* basef, float* outf, int tile, int rh, bf16* xb, float* ss) {
    const int fr = F.lane & 15, fq = F.lane >> 4, n0 = tile * 16, r0 = rh * 32;
    const int nks = K / 32, ks_lo = nks * F.wave / 8, ks_hi = nks * (F.wave + 1) / 8;
    f32x4 acc[2];
#pragma unroll
    for (int m = 0; m < 2; ++m) acc[m] = (f32x4){0.f, 0.f, 0.f, 0.f};
    const bf16* bp = Bt + (size_t)(n0 + fr) * K + fq * 8; const bf16* ap = A + (size_t)(r0 + fr) * K + fq * 8;
#pragma unroll 8
    for (int ks = ks_lo; ks < ks_hi; ++ks) {
        const bf16x8 bv = *(const bf16x8*)(bp + ks * 32);
#pragma unroll
        for (int m = 0; m < 2; ++m) { const bf16x8 av = *(const bf16x8*)(ap + (size_t)m * 16 * K + ks * 32); acc[m] = __builtin_amdgcn_mfma_f32_16x16x32_bf16(av, bv, acc[m], 0, 0, 0); }
    }
    LAS float* red = (LAS float*)F.lds;
#pragma unroll
    for (int m = 0; m < 2; ++m)
#pragma unroll
        for (int j = 0; j < 4; ++j) red[(F.wave * 8 + m * 4 + j) * 64 + F.lane] = acc[m][j];
    __syncthreads();
    { const int idx = F.tid, mj = idx >> 6, ln = idx & 63; float s = 0.f;
#pragma unroll
      for (int w = 0; w < 8; ++w) s += red[(w * 8 + mj) * 64 + ln];
      const int row = r0 + (mj >> 2) * 16 + (ln >> 4) * 4 + (mj & 3), col = n0 + (ln & 15);
      const float v = (BASE_F32 ? basef[(size_t)row * DM + col] : bflo((unsigned)xb[(size_t)row * DM + col])) + s;
      if (OUT_F32) outf[(size_t)row * DM + col] = v;
      else { xb[(size_t)row * DM + col] = (bf16)f2bf(v); float sq = v * v; sq += __shfl_xor(sq, 1); sq += __shfl_xor(sq, 2); sq += __shfl_xor(sq, 4); sq += __shfl_xor(sq, 8); if ((ln & 15) == 0) unsafeAtomicAdd(ss + row, sq); } }
    __syncthreads();
}

__device__ __forceinline__ float silu_mul(float x, float u) { return x / (1.0f + __expf(-x)) * u; }
__device__ __forceinline__ void phase_ffn_act(KArgs ka, const Frame& F, int l) {
    const bf16* gu = (const bf16*)(ka->ws + WS_GU); bf16* abuf = (bf16*)(ka->ws + WS_ABUF);
    const float* cw = ka->in[17] + (size_t)l * 3 * DFF; const float* fst = ka->in[7] + (size_t)l * DB * 2 * DFF;
    const float* halo = (const float*)(ka->ws + WS_FIX); const float* g01 = (const float*)(ka->ws + WS_FIX + FIX_ONE); const float* u01 = (const float*)(ka->ws + WS_FIX + 2 * FIX_ONE);
    const int gt = F.bid * NT + F.tid, NGT = F.G * NT;
    constexpr int NC8 = DFF / 8;
    for (int q = gt; q < (DB + 32) * NC8; q += NGT) {
        const int rc = q / NC8, c = (q - rc * NC8) * 8;
        float w0[8], w1[8], w2[8]; ld8f(cw + c, w0); ld8f(cw + DFF + c, w1); ld8f(cw + 2 * DFF + c, w2);
        if (rc < DB) {
            const int b = rc, r0 = MP + b * 8, gcol = (c >> 7) * 256 + (c & 127);
            const bf16* gp = gu + (size_t)r0 * GUC + gcol;
            v4u gv[8], uv[8];
#pragma unroll
            for (int i = 0; i < 8; ++i) { gv[i] = ld16(gp + (size_t)i * GUC); uv[i] = ld16(gp + (size_t)i * GUC + 128); }
            float g0[8], g1[8], g2[8]; ld8f(fst + ((size_t)b * 2 + 0) * DFF + c, g0); ld8f(fst + ((size_t)b * 2 + 1) * DFF + c, g1);
#pragma unroll
            for (int i = 0; i < 8; ++i) { float u[8], y[8]; unpack8(gv[i], g2); unpack8(uv[i], u);
#pragma unroll
                for (int e = 0; e < 8; ++e) { y[e] = silu_mul(w0[e] * g0[e] + w1[e] * g1[e] + w2[e] * g2[e], u[e]); g0[e] = g1[e]; g1[e] = g2[e]; }
                *(v4u*)(abuf + (size_t)(r0 + i) * DFF + c) = pack8(y); }
            float* so = ka->out + O_FFNS + (((size_t)l * DB + b) * 2) * DFF + c; st8f(so, g0); st8f(so + DFF, g1);
        } else {
            const int pm = rc - DB;
            float g0[8], g1[8], x0[8], x1[8], u0[8], u1[8], y[8];
            if ((pm & 7) == 0) {
#pragma unroll
                for (int e = 0; e < 8; ++e) { g0[e] = 0.f; g1[e] = 0.f; } }
            else { ld8f(halo + (size_t)((pm - 1) * 2 + 0) * DFF + c, g0); ld8f(halo + (size_t)((pm - 1) * 2 + 1) * DFF + c, g1); }
            ld8f(g01 + (size_t)(pm * 2 + 0) * DFF + c, x0); ld8f(g01 + (size_t)(pm * 2 + 1) * DFF + c, x1);
            ld8f(u01 + (size_t)(pm * 2 + 0) * DFF + c, u0); ld8f(u01 + (size_t)(pm * 2 + 1) * DFF + c, u1);
#pragma unroll
            for (int e = 0; e < 8; ++e) y[e] = silu_mul(w0[e] * g0[e] + w1[e] * g1[e] + w2[e] * x0[e], u0[e]);
            *(v4u*)(abuf + (size_t)(pm * 256) * DFF + c) = pack8(y);
#pragma unroll
            for (int e = 0; e < 8; ++e) y[e] = silu_mul(w0[e] * g1[e] + w1[e] * x0[e] + w2[e] * x1[e], u1[e]);
            *(v4u*)(abuf + (size_t)(pm * 256 + 1) * DFF + c) = pack8(y);
        }
    }
}

typedef __attribute__((address_space(1))) unsigned gu32;
#define RLX_AGENT __ATOMIC_RELAXED, __HIP_MEMORY_SCOPE_AGENT
#define XB_TMO      128
#define XB_XCNT(j)  (256  + 64 * (j))
#define XB_XSUB(j)  (1280 + 64 * (j))
#define XB_XGEN(j)  (2304 + 64 * (j))
#define XB_TOP      3328
#define XB_TOPGEN   3392
#define XCD_BAR_WORDS 3456
#define XB_SPIN_CAP (1u << 18)

__device__ __forceinline__ unsigned xb_ld(unsigned* p)              { return __hip_atomic_load(p, __ATOMIC_RELAXED, __HIP_MEMORY_SCOPE_AGENT); }
__device__ __forceinline__ unsigned xb_add(unsigned* p, unsigned v) { return __hip_atomic_fetch_add(p, v, __ATOMIC_RELAXED, __HIP_MEMORY_SCOPE_AGENT); }
__device__ __forceinline__ unsigned xb_xcc_id() { return (unsigned)__builtin_amdgcn_s_getreg((3 << 11) | 20) & 0xFu; }
#define XB_SPIN(cond, bar) do { unsigned _sp = 0; while (cond) { __builtin_amdgcn_s_sleep(1); \
    if ((++_sp & 255u) == 0u) { if (xb_ld(&(bar)[XB_TMO])) break; if (_sp > XB_SPIN_CAP) { atomicAdd(&(bar)[XB_TMO], 1u); break; } } } } while (0)

struct XcdBarrier {
    unsigned* bar; unsigned x;
    volatile LAS unsigned* st;
};

__device__ __forceinline__ XcdBarrier xcd_barrier_post(unsigned* bar, volatile LAS unsigned* st) {
    XcdBarrier b; b.bar = bar; b.x = xb_xcc_id(); b.st = st;
    if (threadIdx.x == 0) (void)xb_add(&bar[XB_XCNT(b.x)], 1u);
    return b;
}
__device__ __forceinline__ void xcd_barrier_complete(unsigned* bar, unsigned x, unsigned& nloc, unsigned& nx) {
    const unsigned G = gridDim.x * gridDim.y * gridDim.z;
    unsigned sum, cnt, mine, sp = 0u;
    for (;;) {
        sum = 0u; cnt = 0u; mine = 0u;
#pragma unroll
        for (unsigned j = 0; j < 16; ++j) { const unsigned c = xb_ld(&bar[XB_XCNT(j)]); sum += c; cnt += (c > 0u) ? 1u : 0u; mine = (j == x) ? c : mine; }
        if (sum == G) break;
        __builtin_amdgcn_s_sleep(1);
        if ((++sp & 255u) == 0u) { if (xb_ld(&bar[XB_TMO])) break; if (sp > XB_SPIN_CAP) { atomicAdd(&bar[XB_TMO], 1u); break; } }
    }
    nloc = mine > 0u ? mine : 1u; nx = cnt > 0u ? cnt : 1u;
}

__device__ __forceinline__ void xcd_barrier(const XcdBarrier& b) {
    asm volatile("s_waitcnt vmcnt(0)" ::: "memory");
    __syncthreads();
    if (threadIdx.x == 0) {
        unsigned* bar = b.bar;
        __builtin_amdgcn_s_waitcnt(0);
        unsigned nloc = b.st[0], nx = b.st[1];
        if (nloc == 0u) { xcd_barrier_complete(bar, b.x, nloc, nx); b.st[0] = nloc; b.st[1] = nx; }
        const unsigned old = xb_add(&bar[XB_XSUB(b.x)], 1u);
        const unsigned gen = old / nloc;
        if (old + 1u == (gen + 1u) * nloc) {
            __builtin_amdgcn_fence(__ATOMIC_RELEASE, "agent");
            asm volatile("s_waitcnt vmcnt(0)" ::: "memory");
            const unsigned og = xb_add(&bar[XB_TOP], 1u);
            const unsigned tg = og / nx;
            if (og + 1u == (tg + 1u) * nx) xb_add(&bar[XB_TOPGEN], 1u);
            else XB_SPIN(xb_ld(&bar[XB_TOPGEN]) == tg, bar);
            __builtin_amdgcn_fence(__ATOMIC_ACQUIRE, "agent");
            xb_add(&bar[XB_XGEN(b.x)], 1u);
            asm volatile("s_waitcnt vmcnt(0)" ::: "memory");
        } else {
            XB_SPIN(xb_ld(&bar[XB_XGEN(b.x)]) == gen, bar);
            __builtin_amdgcn_fence(__ATOMIC_ACQUIRE, "agent");
            asm volatile("s_waitcnt vmcnt(0)" ::: "memory");
        }
    }
    __syncthreads();
}

constexpr int N_PHASES = 16;
#ifndef PHMASK
#define PHMASK 0x3ff
#endif
#define EN(i) (((PHMASK) >> (i)) & 1)
template <int PH> __device__ __forceinline__ void run_phase(KArgs ka, unsigned char* lds_raw) {
    constexpr int l = PH == 0 ? 0 : (PH - 1) / 7, k = PH == 0 ? -1 : (PH == N_PHASES - 1 ? 7 : (PH - 1) % 7);
    asm volatile("" : "+s"(ka));
    Frame F;
    { int tid = threadIdx.x, bid = blockIdx.x, G = gridDim.x; asm volatile("" : "+v"(tid)); asm volatile("" : "+s"(bid), "+s"(G));
      F.lds = (LAS unsigned char*)lds_raw; F.tid = tid; F.lane = tid & 63; F.wave = __builtin_amdgcn_readfirstlane(tid >> 6); F.G = G; F.bid = bid; }
    unsigned char* ws = ka->ws;
    float* xres = (float*)(ws + WS_XRES); bf16* xb = (bf16*)(ws + WS_HB); bf16* proj = (bf16*)(ws + WS_PROJ); bf16* ycat = (bf16*)(ws + WS_YCAT);
    bf16* gu = (bf16*)(ws + WS_GU); bf16* abuf = (bf16*)(ws + WS_ABUF); bf16* dbuf = (bf16*)(ws + WS_DBUF); float* ss = (float*)(ws + WS_SS);
    unsigned char* wl = ws + WS_W + (size_t)l * WL_SIZE;
    if constexpr (k == -1) { if (EN(0)) phase_prep(ka, F); }
    else if constexpr (k == 0) { if (EN(2)) { pg8::Gemm g{xb, (const bf16*)(wl + WL_IN), MPAD, INC, DM}; pg8::StaticOrder S; S.init(MPAD, INC, F.G, F.bid); pg8::EpiStoreBf16 E{proj, INC, ss + (size_t)(2 * l) * MPAD};
        pg8::gemm_phase<pg8::EpiStoreBf16, pg8::StaticOrder, W_IN_ALIGN, true>(F.lds, g, S, E, F.tid);
        if (tailcopy_ok(F.G)) { const int rem = N_UNITS_IN % F.G, rem2 = N_UNITS_GU % F.G, n1 = F.G - rem, n2 = F.G - rem2;
            if (F.bid >= rem) { if (l == 0) convert_items(ka, F, 1, (F.bid - rem) * NWAVES + F.wave, (n1 + n2) * NWAVES); else cache_copy(ka, F, F.bid - rem, n1, 0, COPY_SPLIT); } } } }
    else if constexpr (k == 1) { if (EN(3)) phase_mixers(ka, F, l); }
    else if constexpr (k == 2) { if (EN(4)) { phase_merge(ka, F);
        const int gi = F.bid / 33, pm = F.bid - gi * 33;
        pg8::Gemm g{dbuf + (size_t)(gi & 3) * MPAD * 256, (const bf16*)(wl + WL_PL) + (size_t)(gi & 3) * 65536, MPAD, 256, 256}; pg8::OneUnit S{pm, gi < 4};
        pg8::EpiScaleBf16 E{ycat + 1024 + (gi & 3) * 256, DM, ka->in[13] + (size_t)l * 1024 + (gi & 3) * 256};
        __syncthreads();
        pg8::gemm_phase<pg8::EpiScaleBf16, pg8::OneUnit, false, true>(F.lds, g, S, E, F.tid); } }
    else if constexpr (k == 3 || k == 6) { if (EN(5)) {
        const bf16* A = k == 3 ? ycat : abuf; const bf16* Bt = (const bf16*)(wl + (k == 3 ? WL_OUT : WL_DN)); constexpr int K = k == 3 ? DM : DFF;
        constexpr bool first = (k == 3 && l == 0), last = false;
        float* ssn = ss + (size_t)(2 * l + (k == 3 ? 1 : 2)) * MPAD;
        pg8::Gemm g{A, Bt, MP, DM, K}; pg8::StaticOrder S; S.init(MP, DM, F.G, F.bid); pg8::EpiRes<first, last> E{ka->in[0], xb, xres, xb, ssn, DM};
        pg8::gemm_phase<pg8::EpiRes<first, last>, pg8::StaticOrder, false, true>(F.lds, g, S, E, F.tid);
        __syncthreads();
        for (int t = F.bid; t < 256; t += F.G) skinny_tile<first, last>(F, A + (size_t)MP * K, Bt, K, ka->in[1], xres + (size_t)MP * DM, t & 127, t >> 7, xb + (size_t)MP * DM, ssn + MP); } }
    else if constexpr (k == 4) { if (EN(7)) { pg8::Gemm g{xb, (const bf16*)(wl + WL_GU), MPAD, GUC, DM}; pg8::StaticOrder S; S.init(MPAD, GUC, F.G, F.bid); float* fix = (float*)(ws + WS_FIX);
        pg8::EpiAct E{gu, GUC, abuf, DFF, ss + (size_t)(2 * l + 1) * MPAD, ka->in[17] + (size_t)l * 3 * DFF, fix, fix + FIX_ONE / 4, fix + 2 * (FIX_ONE / 4), ka->out + O_FFNP + (size_t)l * NBATCH * 2 * DFF, (LAS float*)(F.lds + 131072)};
        pg8::gemm_phase<pg8::EpiAct, pg8::StaticOrder, true, true>(F.lds, g, S, E, F.tid);
        if (tailcopy_ok(F.G)) { const int rem = N_UNITS_IN % F.G, rem2 = N_UNITS_GU % F.G, n1 = F.G - rem, n2 = F.G - rem2;
            if (F.bid >= rem2) { if (l == 0) convert_items(ka, F, 1, (n1 + F.bid - rem2) * NWAVES + F.wave, (n1 + n2) * NWAVES); else cache_copy(ka, F, F.bid - rem2, n2, COPY_SPLIT, 1024); } } } }
    else if constexpr (k == 5) { if (EN(8)) phase_ffn_act(ka, F, l); }
    else { if (EN(9)) phase_final(F, xb, ss + (size_t)4 * MPAD, ka->in[19], ka->out + O_YP, ka->out + O_YS); }
}
__global__ void __launch_bounds__(NT, 2) hymba_fwd(Args a_unused) {
    extern __shared__ __attribute__((aligned(16))) unsigned char lds_raw[];
    cg::grid_group grid = cg::this_grid();
    KArgs ka = (KArgs)__builtin_amdgcn_kernarg_segment_ptr();
    const int ph_lo = ka->ph_lo, ph_hi = ka->ph_hi;
    { volatile LAS unsigned* misc = (volatile LAS unsigned*)((LAS unsigned char*)lds_raw + MISC_OFF); if (threadIdx.x < 4) misc[threadIdx.x] = 0u; }
    __syncthreads();
    const XcdBarrier xbar = xcd_barrier_post((unsigned*)ka->ws, (volatile LAS unsigned*)((LAS unsigned char*)lds_raw + MISC_OFF));
#define SEAM(P) do { if (ph_hi > N_PHASES) grid.sync(); else xcd_barrier(xbar); } while (0)
#ifndef DBL_PH
#define DBL_PH -1
#endif
#ifndef XSYNC
#define XSYNC 0
#endif
#define RUN(P) if (ph_lo <= (P) && (P) < ph_hi) { if ((P) == DBL_PH) { run_phase<P>(ka, lds_raw); SEAM(P); } run_phase<P>(ka, lds_raw); if ((P) + 1 < ph_hi) SEAM(P); }
    RUN(0) RUN(1) RUN(2) RUN(3) RUN(4) RUN(5) RUN(6) RUN(7) RUN(8) RUN(9)
    RUN(10) RUN(11) RUN(12) RUN(13) RUN(14) RUN(15)
#undef RUN
    for (int i = 0; i < XSYNC; ++i) xcd_barrier(xbar);
}

extern "C" void kernel_launch(void* const* d_in, const int* in_sizes, int n_in, void* d_out, int out_size, void* d_ws, size_t ws_size, hipStream_t stream) {
    static int grid = 0;
    if (grid == 0) {
        if (n_in != 20 || (size_t)out_size != O_END || ws_size < WS_END) { fprintf(stderr, "kernel_launch: unexpected sizes: n_in %d out %d ws %zu (need %zu)\n", n_in, out_size, ws_size, (size_t)WS_END); grid = -1; return; }
        int dev = 0, cus = 0, per_cu = 0;
        if (hipGetDevice(&dev) != hipSuccess || hipDeviceGetAttribute(&cus, hipDeviceAttributeMultiprocessorCount, dev) != hipSuccess) { grid = -1; return; }
        if (hipFuncSetAttribute((const void*)hymba_fwd, hipFuncAttributeMaxDynamicSharedMemorySize, LDS_BYTES) != hipSuccess) { fprintf(stderr, "kernel_launch: hipFuncSetAttribute failed\n"); grid = -1; return; }
        if (hipOccupancyMaxActiveBlocksPerMultiprocessor(&per_cu, (const void*)hymba_fwd, NT, LDS_BYTES) != hipSuccess || per_cu < 1) { fprintf(stderr, "kernel_launch: occupancy query says %d\n", per_cu); (void)hipGetLastError(); grid = -1; return; }
        grid = cus * 1;
    }
    if (grid < 0) return;
    if (hipMemsetAsync(d_ws, 0, CTL_ZERO_BYTES, stream) != hipSuccess) { fprintf(stderr, "kernel_launch: memset failed\n"); return; }
    Args a{};
    for (int i = 0; i < 20; ++i) a.in[i] = (const float*)d_in[i];
    a.out = (float*)d_out; a.ws = (unsigned char*)d_ws;
#if MK_PER_PHASE
    for (int ph = 0; ph < N_PHASES; ++ph) { a.ph_lo = ph; a.ph_hi = ph + 1; void* args[] = {&a};
        hipError_t e = hipLaunchCooperativeKernel((const void*)hymba_fwd, dim3(grid), dim3(NT), args, LDS_BYTES, stream);
        if (e != hipSuccess) { fprintf(stderr, "cooperative launch failed: %s\n", hipGetErrorString(e)); break; } }
#else
    a.ph_lo = 0; a.ph_hi = N_PHASES; void* args[] = {&a};
    hipError_t e = hipLaunchCooperativeKernel((const void*)hymba_fwd, dim3(grid), dim3(NT), args, LDS_BYTES, stream);
    if (e != hipSuccess) fprintf(stderr, "cooperative launch failed: %s (grid %d)\n", hipGetErrorString(e), grid);
#endif
}
```

```cpp
#include <hip/hip_runtime.h>
#include <hip/hip_cooperative_groups.h>
#include <cstdio>
#include <cstdint>
namespace pg8 {
#define PG8_LAS __attribute__((address_space(3)))
typedef unsigned short bf16_t;
typedef short bf16x8 __attribute__((ext_vector_type(8)));
typedef float f32x4 __attribute__((ext_vector_type(4)));
typedef unsigned u32x4 __attribute__((ext_vector_type(4)));
constexpr int BM = 256, BK = 64, HALF = 128, HTB = HALF * BK * 2  , STAGE_BYTES = 8 * HTB, NXCD = 8, WGM = 8;

__host__ __device__ __forceinline__ int lds_byte(int r, int c) { const int st = (r >> 4) * 2 + (c >> 5), rr = r & 15, cc = c & 31, ob = rr * 64 + cc * 2; return st * 1024 + (ob ^ (((ob >> 9) & 1) << 5)); }
__host__ __device__ __forceinline__ void stage_rc(int b, int& R, int& C) { const int st = b / 1024, sb = b % 1024, swz = sb ^ (((sb >> 9) & 1) << 5); R = (st >> 1) * 16 + swz / 64; C = (st & 1) * 32 + (swz % 64) / 2; }
__host__ __device__ __forceinline__ int perm32(int rho) { const int n = rho >> 4, i = rho & 15; return 8 * (i >> 2) + 4 * n + (i & 3); }

struct Unit { int pm, pn; };
struct Gemm { const bf16_t* A; const bf16_t* Bt; int M, N, K; };

struct StaticOrder {
    int nM, nN, nwg, G, c;
    __host__ __device__ void init(int M, int N, int G_, int c_) { nM = M / BM; nN = N / BM; nwg = nM * nN; G = G_; c = c_; }
    __host__ __device__ bool next(int i, Unit& u) const {
        const long L = (long)i * G + c; if (L >= nwg) return false;
        int wgid = (int)L; { const int q = nwg / NXCD, r = nwg % NXCD, xcd = wgid % NXCD, off = wgid / NXCD; wgid = (xcd < r ? xcd * (q + 1) : r * (q + 1) + (xcd - r) * q) + off; }
        const int nig = WGM * nN, gid = wgid / nig, fm = gid * WGM, gsz = (nM - fm) < WGM ? (nM - fm) : WGM;
        u.pm = fm + ((wgid % nig) % gsz); u.pn = (wgid % nig) / gsz; return true;
    }
    __device__ __forceinline__ void a_ready(const Unit&) const {}
    __device__ __forceinline__ void done(const Unit&) const {}
};
__device__ __forceinline__ unsigned cvt_pk_bf16(float lo, float hi) { unsigned r; asm volatile("v_cvt_pk_bf16_f32 %0, %1, %2" : "=v"(r) : "v"(lo), "v"(hi)); return r; }
struct EpiStoreBf16 {
    static constexpr bool PERM = true, AFTER_DRAIN = false;
    struct State { float s0, s1; };
    bf16_t* O; int ldc; const float* ss;
    __device__ __forceinline__ void pre(State& st, const Unit& u, int wr, int lane) const { const float* p = ss + u.pm * BM + wr * 64 + lane; st.s0 = p[0]; st.s1 = p[HALF]; }
    __device__ __forceinline__ void operator()(const f32x4 (&acc)[2][2][4][2], const Unit& u, int wr, int wc, int fr, int fq, const State& st) const {
        const int row0 = u.pm * BM + wr * 64 + fr, col0 = u.pn * BM + wc * 32 + 8 * fq;
        const float r0 = __builtin_amdgcn_rsqf(st.s0 * (1.0f / 2048.0f) + 1e-6f), r1 = __builtin_amdgcn_rsqf(st.s1 * (1.0f / 2048.0f) + 1e-6f);
#pragma unroll
        for (int ai = 0; ai < 2; ++ai)
#pragma unroll
            for (int m = 0; m < 4; ++m) { const int row = row0 + ai * HALF + m * 16; bf16_t* rowp = O + (size_t)row * ldc + col0;
                const float rs = __shfl(ai ? r1 : r0, m * 16 + fr);
#pragma unroll
                for (int bj = 0; bj < 2; ++bj) { const f32x4 v0 = acc[ai][bj][m][0] * rs, v1 = acc[ai][bj][m][1] * rs;
                    u32x4 w; w.x = cvt_pk_bf16(v0[0], v0[1]); w.y = cvt_pk_bf16(v0[2], v0[3]); w.z = cvt_pk_bf16(v1[0], v1[1]); w.w = cvt_pk_bf16(v1[2], v1[3]);
                    *(u32x4*)(rowp + bj * HALF) = w; } }
    }
};
struct EpiScaleBf16 {
    static constexpr bool PERM = true, AFTER_DRAIN = false;
    struct State {};
    bf16_t* O; int ldc; const float* scale;
    __device__ __forceinline__ void pre(State&, const Unit&, int, int) const {}
    __device__ __forceinline__ void operator()(const f32x4 (&acc)[2][2][4][2], const Unit& u, int wr, int wc, int fr, int fq, const State&) const {
        const int row0 = u.pm * BM + wr * 64 + fr, col0 = wc * 32 + 8 * fq;
#pragma unroll
        for (int ai = 0; ai < 2; ++ai)
#pragma unroll
            for (int m = 0; m < 4; ++m) { bf16_t* rowp = O + (size_t)(row0 + ai * HALF + m * 16) * ldc + col0;
#pragma unroll
                for (int bj = 0; bj < 2; ++bj) { const f32x4 v0 = acc[ai][bj][m][0] * *(const f32x4*)(scale + col0 + bj * HALF), v1 = acc[ai][bj][m][1] * *(const f32x4*)(scale + col0 + bj * HALF + 4);
                    u32x4 w; w.x = cvt_pk_bf16(v0[0], v0[1]); w.y = cvt_pk_bf16(v0[2], v0[3]); w.z = cvt_pk_bf16(v1[0], v1[1]); w.w = cvt_pk_bf16(v1[2], v1[3]);
                    *(u32x4*)(rowp + bj * HALF) = w; } }
    }
};
template <bool BASE_F32, bool OUT_F32> struct EpiRes {
    static constexpr bool PERM = true, AFTER_DRAIN = false;
    struct State {};
    const float* basef; const bf16_t* baseb; float* outf; bf16_t* xb; float* ss; int ldc;
    __device__ __forceinline__ void pre(State&, const Unit&, int, int) const {}
    __device__ __forceinline__ void ldbase(f32x4 (&b)[4], size_t off) const {
        if (BASE_F32) {
#pragma unroll
            for (int q = 0; q < 4; ++q) b[q] = *(const f32x4*)(basef + off + (q >> 1) * HALF + (q & 1) * 4);
        } else {
#pragma unroll
            for (int bj = 0; bj < 2; ++bj) { const u32x4 w = *(const u32x4*)(baseb + off + bj * HALF);
                b[bj * 2] = (f32x4){__builtin_bit_cast(float, w.x << 16), __builtin_bit_cast(float, w.x & 0xffff0000u), __builtin_bit_cast(float, w.y << 16), __builtin_bit_cast(float, w.y & 0xffff0000u)};
                b[bj * 2 + 1] = (f32x4){__builtin_bit_cast(float, w.z << 16), __builtin_bit_cast(float, w.z & 0xffff0000u), __builtin_bit_cast(float, w.w << 16), __builtin_bit_cast(float, w.w & 0xffff0000u)}; }
        }
    }
    __device__ __forceinline__ void operator()(const f32x4 (&acc)[2][2][4][2], const Unit& u, int wr, int wc, int fr, int fq, const State&) const {
        const int row0 = u.pm * BM + wr * 64 + fr, col0 = u.pn * BM + wc * 32 + 8 * fq;
        f32x4 bb[2][4];
        ldbase(bb[0], (size_t)row0 * ldc + col0);
#pragma unroll
        for (int it = 0; it < 8; ++it) { const int ai = it >> 2, m = it & 3; const int row = row0 + ai * HALF + m * 16; const size_t off = (size_t)row * ldc + col0; float sq = 0.f;
            if (it + 1 < 8) ldbase(bb[(it + 1) & 1], (size_t)(row0 + ((it + 1) >> 2) * HALF + ((it + 1) & 3) * 16) * ldc + col0);
            asm volatile("" ::: "memory");
#pragma unroll
            for (int bj = 0; bj < 2; ++bj) { const f32x4 v0 = bb[it & 1][bj * 2] + acc[ai][bj][m][0], v1 = bb[it & 1][bj * 2 + 1] + acc[ai][bj][m][1];
                if (OUT_F32) { *(f32x4*)(outf + off + bj * HALF) = v0; *(f32x4*)(outf + off + bj * HALF + 4) = v1; }
                else { u32x4 w; w.x = cvt_pk_bf16(v0[0], v0[1]); w.y = cvt_pk_bf16(v0[2], v0[3]); w.z = cvt_pk_bf16(v1[0], v1[1]); w.w = cvt_pk_bf16(v1[2], v1[3]);
                    *(u32x4*)(xb + off + bj * HALF) = w;
                    sq += (v0[0] * v0[0] + v0[1] * v0[1]) + (v0[2] * v0[2] + v0[3] * v0[3]) + (v1[0] * v1[0] + v1[1] * v1[1]) + (v1[2] * v1[2] + v1[3] * v1[3]); } }
            if (!OUT_F32) { sq += __shfl_xor(sq, 16); sq += __shfl_xor(sq, 32); if (fq == 0) unsafeAtomicAdd(ss + row, sq); }
        }
    }
};
__device__ __forceinline__ float dpp_ror1(float v) { return __builtin_bit_cast(float, __builtin_amdgcn_update_dpp(0, __builtin_bit_cast(int, v), 0x121, 0xf, 0xf, false)); }
__device__ __forceinline__ float dpp_ror2(float v) { return __builtin_bit_cast(float, __builtin_amdgcn_update_dpp(0, __builtin_bit_cast(int, v), 0x122, 0xf, 0xf, false)); }
struct EpiAct {
    static constexpr bool PERM = true, AFTER_DRAIN = false;
    struct State { float s0, s1; };
    bf16_t* GUo; int ldgu; bf16_t* Ab; int dff; const float* ss; const float* cw; float* halo; float* g01; float* u01; float* fstate; PG8_LAS float* lh;
    __device__ __forceinline__ void pre(State& st, const Unit& u, int wr, int lane) const { const float* p = ss + u.pm * BM + wr * 64 + lane; st.s0 = p[0]; st.s1 = p[HALF]; }
    __device__ __forceinline__ void operator()(const f32x4 (&acc)[2][2][4][2], const Unit& u, int wr, int wc, int fr, int fq, const State& st) const {
        const float r0 = __builtin_amdgcn_rsqf(st.s0 * (1.0f / 2048.0f) + 1e-6f), r1 = __builtin_amdgcn_rsqf(st.s1 * (1.0f / 2048.0f) + 1e-6f);
        if (u.pm >= 32) {
            const int row0 = u.pm * BM + wr * 64 + fr, col0 = u.pn * BM + wc * 32 + 8 * fq;
#pragma unroll
            for (int ai = 0; ai < 2; ++ai)
#pragma unroll
                for (int m = 0; m < 4; ++m) { bf16_t* rowp = GUo + (size_t)(row0 + ai * HALF + m * 16) * ldgu + col0; const float rs = __shfl(ai ? r1 : r0, m * 16 + fr);
#pragma unroll
                    for (int bj = 0; bj < 2; ++bj) { const f32x4 v0 = acc[ai][bj][m][0] * rs, v1 = acc[ai][bj][m][1] * rs;
                        u32x4 w; w.x = cvt_pk_bf16(v0[0], v0[1]); w.y = cvt_pk_bf16(v0[2], v0[3]); w.z = cvt_pk_bf16(v1[0], v1[1]); w.w = cvt_pk_bf16(v1[2], v1[3]);
                        *(u32x4*)(rowp + bj * HALF) = w; } }
            return;
        }
        const int cc = wc * 32 + 8 * fq, ch = u.pn * HALF + cc;
        f32x4 w0[2], w1[2], w2[2];
#pragma unroll
        for (int n = 0; n < 2; ++n) { w0[n] = *(const f32x4*)(cw + ch + 4 * n); w1[n] = *(const f32x4*)(cw + dff + ch + 4 * n); w2[n] = *(const f32x4*)(cw + 2 * dff + ch + 4 * n); }
#pragma unroll
        for (int ai = 0; ai < 2; ++ai) { const int bi = 2 * ai + wr; const float rs = __shfl(ai ? r1 : r0, 48 + fr);
            if (fr >= 14) {
#pragma unroll
                for (int n = 0; n < 2; ++n) { const f32x4 gv = acc[ai][0][3][n] * rs; *(PG8_LAS f32x4*)(lh + (bi * 2 + (fr - 14)) * HALF + cc + 4 * n) = gv;
                    if (bi == 3) { *(f32x4*)(halo + (size_t)(u.pm * 2 + (fr - 14)) * dff + ch + 4 * n) = gv;
                        if ((u.pm & 7) == 7) *(f32x4*)(fstate + (size_t)((u.pm >> 3) * 2 + (fr - 14)) * dff + ch + 4 * n) = gv; } }
            } }
        asm volatile("s_waitcnt lgkmcnt(0)" ::: "memory"); __builtin_amdgcn_s_barrier(); asm volatile("" ::: "memory");
#pragma unroll
        for (int ai = 0; ai < 2; ++ai) { const int bi = 2 * ai + wr;
            float p1c[8], p2c[8];
            { f32x4 hp[2];
#pragma unroll
              for (int n = 0; n < 2; ++n) hp[n] = bi > 0 ? *(const PG8_LAS f32x4*)(lh + ((bi - 1) * 2 + (fr & 1)) * HALF + cc + 4 * n) : (f32x4){0.f, 0.f, 0.f, 0.f};
#pragma unroll
              for (int i = 0; i < 8; ++i) { p1c[i] = dpp_ror1(hp[i >> 2][i & 3]); p2c[i] = dpp_ror2(hp[i >> 2][i & 3]); } }
#pragma unroll
            for (int m = 0; m < 4; ++m) { const float rs = __shfl(ai ? r1 : r0, m * 16 + fr); const int row = u.pm * BM + ai * HALF + wr * 64 + m * 16 + fr;
                float a8[8], g8[8], u8[8];
#pragma unroll
                for (int i = 0; i < 8; ++i) { const int n = i >> 2, e = i & 3;
                    const float cur = acc[ai][0][m][n][e] * rs, up = acc[ai][1][m][n][e] * rs;
                    const float c1 = dpp_ror1(cur), c2 = dpp_ror2(cur);
                    const float q1 = fr >= 1 ? c1 : p1c[i], q2 = fr >= 2 ? c2 : p2c[i];
                    const float gc = w0[n][e] * q2 + w1[n][e] * q1 + w2[n][e] * cur;
                    a8[i] = gc * __builtin_amdgcn_rcpf(1.0f + __expf(-gc)) * up;
                    g8[i] = cur; u8[i] = up; p1c[i] = c1; p2c[i] = c2; }
                if (bi == 0 && m == 0 && fr < 2) {
                    float* gp = g01 + (size_t)(u.pm * 2 + fr) * dff + ch; float* up_ = u01 + (size_t)(u.pm * 2 + fr) * dff + ch;
                    *(f32x4*)gp = (f32x4){g8[0], g8[1], g8[2], g8[3]}; *(f32x4*)(gp + 4) = (f32x4){g8[4], g8[5], g8[6], g8[7]};
                    *(f32x4*)up_ = (f32x4){u8[0], u8[1], u8[2], u8[3]}; *(f32x4*)(up_ + 4) = (f32x4){u8[4], u8[5], u8[6], u8[7]};
                } else { u32x4 w; w.x = cvt_pk_bf16(a8[0], a8[1]); w.y = cvt_pk_bf16(a8[2], a8[3]); w.z = cvt_pk_bf16(a8[4], a8[5]); w.w = cvt_pk_bf16(a8[6], a8[7]);
                    *(u32x4*)(Ab + (size_t)row * dff + ch) = w; }
            } }
    }
};
struct OneUnit {
    int pm; bool valid;
    __device__ __forceinline__ bool next(int i, Unit& u) const { if (i != 0 || !valid) return false; u.pm = pm; u.pn = 0; return true; }
    __device__ __forceinline__ void a_ready(const Unit&) const {}
    __device__ __forceinline__ void done(const Unit&) const {}
};
template <class Epi, class Sched, bool ALIGN_EPI = false, bool SP2 = false>
__device__ __forceinline__ void gemm_phase(PG8_LAS unsigned char* lds, const Gemm g, const Sched& S, const Epi& E, const int tid) {
    const int wid = __builtin_amdgcn_readfirstlane(tid >> 6), lane = tid & 63, wr = wid >> 2, wc = wid & 3, fr = lane & 15, fq = lane >> 4;
    const int K = g.K, nt = K / BK;
    unsigned voffA[2], voffB[2];
#pragma unroll
    for (int i = 0; i < 2; ++i) { int R, C; stage_rc(tid * 16 + i * 8192, R, C); const int Rb = Epi::PERM ? ((R & ~31) + perm32(R & 31)) : R;
        voffA[i] = (unsigned)(R * K + C) * 2u; voffB[i] = (unsigned)(Rb * K + C) * 2u; }
    const size_t kstep = (size_t)(BK * 2);
    const size_t hstep = (size_t)HALF * K * 2;
    const size_t tstep = 2 * hstep;
    const unsigned ldsw = (unsigned)wid * 1024u;
    const int aoff = lds_byte(wr * 64 + fr, fq * 8), boff = lds_byte(wc * 32 + fr, fq * 8);
#define PG8_SA(b, h) (((b) * 2 + (h)) * HTB)
#define PG8_SB(b, h) ((4 + (b) * 2 + (h)) * HTB)
#define PG8_STAGE(bufoff, gbase, voff) do { _Pragma("unroll") for (int _i = 0; _i < 2; ++_i) \
        __builtin_amdgcn_global_load_lds((const unsigned*)((const char*)(gbase) + (voff)[_i]), (PG8_LAS unsigned*)(lds + (bufoff) + ldsw + _i * 8192), 16, 0, 0); } while (0)
#define PG8_LDA(dst, b, h) do { _Pragma("unroll") for (int m = 0; m < 4; ++m) _Pragma("unroll") for (int k = 0; k < 2; ++k) dst[m][k] = *(const PG8_LAS bf16x8*)(lds + PG8_SA(b, h) + aoff + m * 2048 + k * 1024); } while (0)
#define PG8_LDB(dst, b, h) do { _Pragma("unroll") for (int n = 0; n < 2; ++n) _Pragma("unroll") for (int k = 0; k < 2; ++k) dst[n][k] = *(const PG8_LAS bf16x8*)(lds + PG8_SB(b, h) + boff + n * 2048 + k * 1024); } while (0)
#define PG8_MMA(ai, bj, At, Bt) do { __builtin_amdgcn_s_setprio(1); _Pragma("unroll") for (int m = 0; m < 4; ++m) _Pragma("unroll") for (int n = 0; n < 2; ++n) _Pragma("unroll") for (int k = 0; k < 2; ++k) \
        acc[ai][bj][m][n] = __builtin_amdgcn_mfma_f32_16x16x32_bf16(Bt[n][k], At[m][k], acc[ai][bj][m][n], 0, 0, 0); __builtin_amdgcn_s_setprio(0); } while (0)
#define PG8_WAIT_V(n) asm volatile("s_waitcnt vmcnt(" #n ")" ::: "memory")
#define PG8_WAIT_L(n) asm volatile("s_waitcnt lgkmcnt(" #n ")" ::: "memory")
#define PG8_BAR __builtin_amdgcn_s_barrier()
#define PG8_SCHED __builtin_amdgcn_sched_barrier(0)
    Unit cur, nxt; int ui = 0;
    if (!S.next(0, cur)) return;
    f32x4 acc[2][2][4][2];
#pragma unroll
    for (int a = 0; a < 2; ++a)
#pragma unroll
        for (int b = 0; b < 2; ++b)
#pragma unroll
            for (int m = 0; m < 4; ++m)
#pragma unroll
                for (int n = 0; n < 2; ++n) acc[a][b][m][n] = (f32x4){0.f, 0.f, 0.f, 0.f};
    bf16x8 At[4][2], B0[2][2], B1[2][2];
    typename Epi::State est;
    const char* cA = (const char*)g.A + (size_t)cur.pm * tstep; const char* cB = (const char*)g.Bt + (size_t)cur.pn * tstep;
    S.a_ready(cur);
    if constexpr (SP2) {
        PG8_STAGE(PG8_SB(0, 0), cB, voffB); PG8_STAGE(PG8_SB(0, 1), cB + hstep, voffB); PG8_STAGE(PG8_SA(0, 0), cA, voffA); PG8_STAGE(PG8_SA(0, 1), cA + hstep, voffA);
        if (wr == 1) PG8_BAR;
        PG8_WAIT_V(2); PG8_BAR;
        PG8_STAGE(PG8_SB(1, 0), cB + kstep, voffB); PG8_STAGE(PG8_SA(1, 0), cA + kstep, voffA); PG8_STAGE(PG8_SB(1, 1), cB + hstep + kstep, voffB);
        PG8_WAIT_V(6); PG8_BAR;
    } else {
        PG8_STAGE(PG8_SB(0, 0), cB, voffB); PG8_STAGE(PG8_SA(0, 0), cA, voffA); PG8_STAGE(PG8_SB(0, 1), cB + hstep, voffB); PG8_STAGE(PG8_SA(0, 1), cA + hstep, voffA);
        if (wr == 1) PG8_BAR;
        PG8_WAIT_V(4); PG8_BAR;
        PG8_STAGE(PG8_SB(1, 0), cB + kstep, voffB); PG8_STAGE(PG8_SA(1, 0), cA + kstep, voffA); PG8_STAGE(PG8_SB(1, 1), cB + hstep + kstep, voffB);
        PG8_WAIT_V(6); PG8_BAR;
    }
    for (;;) {
        const bool has_next = S.next(ui + 1, nxt);
        const char* nA = has_next ? (const char*)g.A + (size_t)nxt.pm * tstep : cA; const char* nB = has_next ? (const char*)g.Bt + (size_t)nxt.pn * tstep : cB;
        for (int t = 0; t < nt; t += 2) {
            const bool last = (t == nt - 2);
            const char* a1 = cA + (size_t)(t + 1) * kstep;
            const char* a2 = last ? nA : cA + (size_t)(t + 2) * kstep; const char* b2 = last ? nB : cB + (size_t)(t + 2) * kstep;
            const char* a3 = a2 + kstep; const char* b3 = b2 + kstep;
            if (last && has_next) S.a_ready(nxt);
            if (last) E.pre(est, cur, wr, lane);
            if constexpr (SP2) {
            PG8_LDB(B0, 0, 0); PG8_LDB(B1, 0, 1); PG8_SCHED; PG8_LDA(At, 0, 0); PG8_STAGE(PG8_SA(1, 1), a1 + hstep, voffA);
            PG8_WAIT_V(8); PG8_WAIT_L(0); PG8_BAR; PG8_MMA(0, 0, At, B0); PG8_MMA(0, 1, At, B1); PG8_BAR; PG8_SCHED;
            PG8_LDA(At, 0, 1); PG8_STAGE(PG8_SB(0, 0), b2, voffB); PG8_STAGE(PG8_SB(0, 1), b2 + hstep, voffB); PG8_STAGE(PG8_SA(0, 0), a2, voffA);
            PG8_WAIT_V(8); PG8_WAIT_L(0); PG8_BAR; PG8_MMA(1, 0, At, B0); PG8_MMA(1, 1, At, B1); PG8_BAR; PG8_SCHED;
            PG8_LDB(B0, 1, 0); PG8_LDB(B1, 1, 1); PG8_SCHED; PG8_LDA(At, 1, 0); PG8_STAGE(PG8_SA(0, 1), a2 + hstep, voffA);
            PG8_WAIT_V(8); PG8_WAIT_L(0); PG8_BAR; PG8_MMA(0, 0, At, B0); PG8_MMA(0, 1, At, B1); PG8_BAR; PG8_SCHED;
            PG8_LDA(At, 1, 1); PG8_STAGE(PG8_SB(1, 0), b3, voffB); PG8_STAGE(PG8_SB(1, 1), b3 + hstep, voffB); PG8_STAGE(PG8_SA(1, 0), a3, voffA);
            PG8_WAIT_V(8); PG8_WAIT_L(0); PG8_BAR; PG8_MMA(1, 0, At, B0); PG8_MMA(1, 1, At, B1); PG8_BAR; PG8_SCHED;
            } else {
            PG8_LDB(B0, 0, 0); PG8_SCHED; PG8_LDA(At, 0, 0); PG8_STAGE(PG8_SA(1, 1), a1 + hstep, voffA);
            PG8_WAIT_L(8); PG8_BAR; PG8_WAIT_L(0); PG8_MMA(0, 0, At, B0); PG8_BAR; PG8_SCHED;
            PG8_LDB(B1, 0, 1); PG8_STAGE(PG8_SB(0, 0), b2, voffB);
            PG8_BAR; PG8_WAIT_L(0); PG8_MMA(0, 1, At, B1); PG8_BAR;
            PG8_LDA(At, 0, 1); PG8_STAGE(PG8_SA(0, 0), a2, voffA);
            PG8_BAR; PG8_WAIT_L(0); PG8_MMA(1, 0, At, B0); PG8_BAR; PG8_SCHED;
            PG8_STAGE(PG8_SB(0, 1), b2 + hstep, voffB);
            PG8_WAIT_V(6); PG8_BAR; PG8_MMA(1, 1, At, B1); PG8_BAR;
            PG8_LDB(B0, 1, 0); PG8_SCHED; PG8_LDA(At, 1, 0); PG8_STAGE(PG8_SA(0, 1), a2 + hstep, voffA);
            PG8_WAIT_L(8); PG8_BAR; PG8_WAIT_L(0); PG8_MMA(0, 0, At, B0); PG8_BAR; PG8_SCHED;
            PG8_LDB(B1, 1, 1); PG8_STAGE(PG8_SB(1, 0), b3, voffB);
            PG8_BAR; PG8_WAIT_L(0); PG8_MMA(0, 1, At, B1); PG8_BAR;
            PG8_LDA(At, 1, 1); PG8_STAGE(PG8_SA(1, 0), a3, voffA);
            PG8_BAR; PG8_WAIT_L(0); PG8_MMA(1, 0, At, B0); PG8_BAR; PG8_SCHED;
            PG8_STAGE(PG8_SB(1, 1), b3 + hstep, voffB);
            PG8_WAIT_V(6); PG8_BAR; PG8_MMA(1, 1, At, B1); PG8_BAR;
            }
        }
        if constexpr (ALIGN_EPI) { if (wr == 0) PG8_BAR; }
        if constexpr (!Epi::AFTER_DRAIN) { E(acc, cur, wr, wc, fr, fq, est); S.done(cur); }
        if (!has_next) break;
#pragma unroll
        for (int a = 0; a < 2; ++a)
#pragma unroll
            for (int b = 0; b < 2; ++b)
#pragma unroll
                for (int m = 0; m < 4; ++m)
#pragma unroll
                    for (int n = 0; n < 2; ++n) acc[a][b][m][n] = (f32x4){0.f, 0.f, 0.f, 0.f};
        cur = nxt; cA = nA; cB = nB; ++ui;
        if constexpr (ALIGN_EPI) { if (wr == 1) PG8_BAR; }
    }
    PG8_WAIT_V(0);
    if constexpr (!ALIGN_EPI) { if (wr == 0) PG8_BAR; }
    PG8_BAR;
    if constexpr (Epi::AFTER_DRAIN) { E.fused(acc, cur, wr, wc, fr, fq, lds, wid, lane); S.done(cur); }
#undef PG8_SA
#undef PG8_SB
#undef PG8_STAGE
#undef PG8_LDA
#undef PG8_LDB
#undef PG8_MMA
#undef PG8_WAIT_V
#undef PG8_WAIT_L
#undef PG8_BAR
#undef PG8_SCHED
}
}


namespace cg = cooperative_groups;
#define LAS __attribute__((address_space(3)))
typedef unsigned short bf16;
typedef unsigned v4u __attribute__((ext_vector_type(4)));
typedef unsigned v2u __attribute__((ext_vector_type(2)));
typedef float f32x4 __attribute__((ext_vector_type(4)));
typedef float f32x2 __attribute__((ext_vector_type(2)));
typedef short bf16x8 __attribute__((ext_vector_type(8)));
typedef short bf16x4 __attribute__((ext_vector_type(4)));
#define LDS_WAIT() asm volatile("s_waitcnt lgkmcnt(0)" ::: "memory")

#ifndef W_IN_ALIGN
#define W_IN_ALIGN true
#endif
#ifndef MIX_DBL
#define MIX_DBL 0
#endif
#ifndef MK_PER_PHASE
#define MK_PER_PHASE 0
#endif

constexpr int NT = 512, NWAVES = 8;
constexpr int DM = 2048, NBATCH = 4, SEQ = 2048, DEPTH = 2, DB = 8, DSQ = 8, PAST = 16384;
constexpr int MP = NBATCH * SEQ, MS = DB * DSQ, MT = MP + MS, MPAD = 8448;
constexpr int INC = 7168, DFF = 5504, GUC = 2 * DFF;
constexpr int QKV0 = 1536, POOL0 = 6144;
constexpr float RMS_EPS = 1e-6f;
constexpr float LOG2E = 1.4426950408889634f, LN2 = 0.6931471805599453f;

constexpr size_t O_YP = 0, O_YS = O_YP + (size_t)MP * DM;
constexpr size_t O_KV128P = O_YS + (size_t)MS * DM,            O_KV128S = O_KV128P + (size_t)DEPTH * NBATCH * 128 * 1024;
constexpr size_t O_KV512P = O_KV128S + (size_t)DEPTH * DB * 128 * 1024,  O_KV512S = O_KV512P + (size_t)DEPTH * NBATCH * 512 * 1024;
constexpr size_t O_KV2048P = O_KV512S + (size_t)DEPTH * DB * 512 * 1024, O_KV2048S = O_KV2048P + (size_t)DEPTH * NBATCH * 2048 * 1024;
constexpr size_t O_CONVP = O_KV2048S + (size_t)DEPTH * DB * 2048 * 1024, O_CONVS = O_CONVP + (size_t)DEPTH * NBATCH * 2 * 512;
constexpr size_t O_POOLP = O_CONVS + (size_t)DEPTH * DB * 2 * 512,       O_POOLS = O_POOLP + (size_t)DEPTH * NBATCH * 15 * 1024;
constexpr size_t O_FFNP = O_POOLS + (size_t)DEPTH * DB * 15 * 1024,      O_FFNS = O_FFNP + (size_t)DEPTH * NBATCH * 2 * DFF;
constexpr size_t O_END = O_FFNS + (size_t)DEPTH * DB * 2 * DFF;
static_assert(O_END == 83625984, "output map");

constexpr size_t al256(size_t x) { return (x + 255) & ~(size_t)255; }
constexpr size_t W_IN_B = (size_t)INC * DM * 2, W_OUT_B = (size_t)DM * DM * 2, W_GU_B = (size_t)GUC * DM * 2, W_DN_B = (size_t)DM * DFF * 2, W_PL_B = (size_t)4 * 256 * 256 * 2;
constexpr size_t WL_IN = 0, WL_OUT = WL_IN + W_IN_B, WL_GU = WL_OUT + W_OUT_B, WL_DN = WL_GU + W_GU_B, WL_PL = WL_DN + W_DN_B, WL_SIZE = WL_PL + W_PL_B;
constexpr size_t WS_W = 1u << 20;
constexpr size_t CTL_ZERO_BYTES = 16384;
constexpr size_t WS_SS = 65536;
static_assert(WS_SS + (size_t)5 * MPAD * 4 <= WS_W, "ss map");
constexpr int MISC_OFF = 143360;
constexpr size_t WS_XRES = al256(WS_W + DEPTH * WL_SIZE);
constexpr size_t WS_HB = al256(WS_XRES + (size_t)MPAD * DM * 4);
constexpr size_t WS_ABUF = al256(WS_HB + (size_t)MPAD * DM * 2);
constexpr size_t WS_R1 = al256(WS_ABUF + (size_t)MPAD * DFF * 2);
constexpr size_t WS_PROJ = WS_R1;
constexpr size_t WS_YCAT = al256(WS_PROJ + (size_t)MPAD * INC * 2);
constexpr size_t WS_OPART = al256(WS_YCAT + (size_t)MPAD * DM * 2);
constexpr size_t WS_LSE = al256(WS_OPART + (size_t)3 * MPAD * 512 * 2);
constexpr size_t WS_DBUF = al256(WS_LSE + (size_t)3 * MPAD * 4 * 4);
constexpr size_t WS_R1END = al256(WS_DBUF + (size_t)4 * MPAD * 256 * 2);
constexpr size_t WS_GU = WS_R1;
constexpr size_t WS_GUEND = al256(WS_GU + (size_t)MPAD * GUC * 2);
constexpr size_t WS_FIX = WS_R1END > WS_GUEND ? WS_R1END : WS_GUEND;
constexpr size_t FIX_ONE = (size_t)32 * 2 * DFF * 4;
constexpr size_t WS_END = al256(WS_FIX + 3 * FIX_ONE);

constexpr int LDS_BYTES = 147456;
constexpr int VT_PITCH = 264;

struct Args { const float* in[20]; float* out; unsigned char* ws; int ph_lo, ph_hi; };
typedef const __attribute__((address_space(4))) Args* KArgs;

struct Frame {
    LAS unsigned char* lds;
    int tid, lane, wave, G, bid;
};

__device__ __forceinline__ unsigned f2bf(float f) { unsigned u = __builtin_bit_cast(unsigned, f); return (u + 0x7fffu + ((u >> 16) & 1u)) >> 16; }
__device__ __forceinline__ unsigned pk2(float lo, float hi) { return f2bf(lo) | (f2bf(hi) << 16); }
__device__ __forceinline__ float bflo(unsigned w) { return __builtin_bit_cast(float, w << 16); }
__device__ __forceinline__ float bfhi(unsigned w) { return __builtin_bit_cast(float, w & 0xffff0000u); }
__device__ __forceinline__ void unpack8(const v4u w, float (&f)[8]) { f[0] = bflo(w.x); f[1] = bfhi(w.x); f[2] = bflo(w.y); f[3] = bfhi(w.y); f[4] = bflo(w.z); f[5] = bfhi(w.z); f[6] = bflo(w.w); f[7] = bfhi(w.w); }
__device__ __forceinline__ v4u pack8(const float (&f)[8]) { v4u w; w.x = pk2(f[0], f[1]); w.y = pk2(f[2], f[3]); w.z = pk2(f[4], f[5]); w.w = pk2(f[6], f[7]); return w; }
__device__ __forceinline__ v4u ld16(const bf16* p) { return *(const v4u*)p; }
__device__ __forceinline__ void ld8f(const float* p, float (&f)[8]) { const f32x4 a = *(const f32x4*)p, b = *(const f32x4*)(p + 4); f[0] = a.x; f[1] = a.y; f[2] = a.z; f[3] = a.w; f[4] = b.x; f[5] = b.y; f[6] = b.z; f[7] = b.w; }
__device__ __forceinline__ void st8f(float* p, const float (&f)[8]) { *(f32x4*)p = (f32x4){f[0], f[1], f[2], f[3]}; *(f32x4*)(p + 4) = (f32x4){f[4], f[5], f[6], f[7]}; }
__device__ __forceinline__ float wave_sum(float v) {
#pragma unroll
    for (int o = 1; o < 64; o <<= 1) v += __shfl_xor(v, o);
    return v;
}
__device__ __forceinline__ float wave_max(float v) {
#pragma unroll
    for (int o = 1; o < 64; o <<= 1) v = fmaxf(v, __shfl_xor(v, o));
    return v;
}
__device__ __forceinline__ int win_of(int g) { return g == 0 ? 128 : (g == 1 ? 512 : 2048); }
__device__ __forceinline__ int dil_of(int g) { return g == 0 ? 1 : (g == 1 ? 4 : 16); }
__device__ __forceinline__ size_t okvp_of(int g) { return g == 0 ? O_KV128P : (g == 1 ? O_KV512P : O_KV2048P); }
__device__ __forceinline__ size_t okvs_of(int g) { return g == 0 ? O_KV128S : (g == 1 ? O_KV512S : O_KV2048S); }

__device__ __forceinline__ void transpose_item(const float* W, int K, int N, bf16* WT, int k0, int n0, int drow0, LAS float* scr, int lane, const float* gain = nullptr) {
    const int c = lane & 7;
    float gn[8];
    if (gain) ld8f(gain + k0 + 8 * c, gn);
    else {
#pragma unroll
        for (int e = 0; e < 8; ++e) gn[e] = 1.0f; }
    float wv[32];
#pragma unroll
    for (int i = 0; i < 32; ++i) { const int kk = 2 * i + (lane >> 5); wv[i] = __builtin_nontemporal_load(W + (size_t)(k0 + kk) * N + n0 + (lane & 31)); }
#pragma unroll
    for (int i = 0; i < 32; ++i) { const int kk = 2 * i + (lane >> 5); scr[kk * 33 + (lane & 31)] = wv[i]; }
    LDS_WAIT();
#pragma unroll
    for (int j = 0; j < 4; ++j) { const int n = (lane >> 3) + 8 * j; const LAS float* s = scr + (8 * c) * 33 + n;
        v4u o; o.x = pk2(s[0 * 33] * gn[0], s[1 * 33] * gn[1]); o.y = pk2(s[2 * 33] * gn[2], s[3 * 33] * gn[3]); o.z = pk2(s[4 * 33] * gn[4], s[5 * 33] * gn[5]); o.w = pk2(s[6 * 33] * gn[6], s[7 * 33] * gn[7]);
        *(v4u*)(WT + (size_t)(drow0 + n) * K + k0 + 8 * c) = o; }
    LDS_WAIT();
}
constexpr int N_UNITS_IN = (MPAD / 256) * (INC / 256), N_UNITS_GU = (MPAD / 256) * (GUC / 256);
__device__ __forceinline__ bool tailcopy_ok(int G) { return (N_UNITS_IN % G) != 0 && (N_UNITS_GU % G) != 0; }
__device__ __forceinline__ void cache_copy(KArgs ka, const Frame& F, int w, int nw) {
    constexpr size_t R0 = (size_t)(128 - 8) * 256, R1 = (size_t)(512 - 8) * 256, R2 = (size_t)(2048 - 8) * 256;
    constexpr size_t T0 = R0 * DEPTH * DB, T1 = R1 * DEPTH * DB, T2 = R2 * DEPTH * DB, N4 = T0 + T1 + T2;
    const size_t lo = N4 * (size_t)w / (size_t)nw, hi = N4 * (size_t)(w + 1) / (size_t)nw;
    const f32x4* s0 = (const f32x4*)ka->in[2]; const f32x4* s1 = (const f32x4*)ka->in[3]; const f32x4* s2 = (const f32x4*)ka->in[4];
    float* outp = ka->out;
    for (size_t q0 = lo + F.tid; q0 < hi; q0 += 8 * NT) {
        f32x4 v[8]; f32x4* d[8];
#pragma unroll
        for (int u = 0; u < 8; ++u) { size_t q = q0 + (size_t)u * NT; if (q >= hi) q = lo;
            const f32x4* src; f32x4* dst; size_t run4, win4;
            if (q < T0) { src = s0; dst = (f32x4*)(outp + O_KV128S); run4 = R0; win4 = 128 * 256; }
            else if (q < T0 + T1) { q -= T0; src = s1; dst = (f32x4*)(outp + O_KV512S); run4 = R1; win4 = 512 * 256; }
            else { q -= T0 + T1; src = s2; dst = (f32x4*)(outp + O_KV2048S); run4 = R2; win4 = 2048 * 256; }
            const size_t lb = q / run4, rem = q - lb * run4, o = lb * win4 + rem;
            v[u] = __builtin_nontemporal_load(src + o + 2048); d[u] = dst + o; }
#pragma unroll
        for (int u = 0; u < 8; ++u) if (q0 + (size_t)u * NT < hi) __builtin_nontemporal_store(v[u], d[u]);
    }
}
__device__ __forceinline__ void convert_items(KArgs ka, const Frame& F, int l, int wv, int nwv) {
    LAS float* scr = (LAS float*)(F.lds + F.wave * 16384);
    constexpr int I_IN = (DM / 64) * (INC / 32), I_OUT = (DM / 64) * (DM / 32), I_G = (DM / 64) * (DFF / 32), I_D = (DFF / 64) * (DM / 32), I_P = 4 * 4 * 8;
    constexpr int I_LAYER = I_IN + I_OUT + 2 * I_G + I_D + I_P;
    unsigned char* wl = ka->ws + WS_W + (size_t)l * WL_SIZE;
    for (int it = wv; it < I_LAYER; it += nwv) {
        int r = it;
        if (r < I_IN) { const int nb = INC / 32, kb = r / nb, n0 = (r % nb) * 32; transpose_item(ka->in[9] + (size_t)l * DM * INC, DM, INC, (bf16*)(wl + WL_IN), kb * 64, n0, n0, scr, F.lane, ka->in[8] + (size_t)l * DM); continue; } r -= I_IN;
        if (r < I_OUT) { const int nb = DM / 32, kb = r / nb, n0 = (r % nb) * 32; transpose_item(ka->in[11] + (size_t)l * DM * DM, DM, DM, (bf16*)(wl + WL_OUT), kb * 64, n0, n0, scr, F.lane); continue; } r -= I_OUT;
        if (r < I_G) { const int nb = DFF / 32, kb = r / nb, n0 = (r % nb) * 32; transpose_item(ka->in[15] + (size_t)l * DM * DFF, DM, DFF, (bf16*)(wl + WL_GU), kb * 64, n0, (n0 >> 7) * 256 + (n0 & 127), scr, F.lane, ka->in[14] + (size_t)l * DM); continue; } r -= I_G;
        if (r < I_G) { const int nb = DFF / 32, kb = r / nb, n0 = (r % nb) * 32; transpose_item(ka->in[16] + (size_t)l * DM * DFF, DM, DFF, (bf16*)(wl + WL_GU), kb * 64, n0, (n0 >> 7) * 256 + 128 + (n0 & 127), scr, F.lane, ka->in[14] + (size_t)l * DM); continue; } r -= I_G;
        if (r < I_D) { const int nb = DM / 32, kb = r / nb, n0 = (r % nb) * 32; transpose_item(ka->in[18] + (size_t)l * DFF * DM, DFF, DM, (bf16*)(wl + WL_DN), kb * 64, n0, n0, scr, F.lane); continue; } r -= I_D;
        { const int g = r / 32, rr = r % 32, kb = rr / 8, n0 = (rr % 8) * 32; transpose_item(ka->in[12] + ((size_t)l * 4 + g) * 65536, 256, 256, (bf16*)(wl + WL_PL) + (size_t)g * 65536, kb * 64, n0, n0, scr, F.lane); }
    }
}
__device__ __forceinline__ void phase_prep(KArgs ka, const Frame& F) {
    const int gw = F.bid * NWAVES + F.wave, NGW = F.G * NWAVES;
    convert_items(ka, F, 0, gw, NGW);
    if (!tailcopy_ok(F.G)) { for (int l = 1; l < DEPTH; ++l) convert_items(ka, F, l, gw, NGW); }
    {
        bf16* xb = (bf16*)(ka->ws + WS_HB); float* ss = (float*)(ka->ws + WS_SS);
        for (int r = gw; r < MT; r += NGW) {
            const f32x4* xr = (const f32x4*)(r < MP ? ka->in[0] + (size_t)r * DM : ka->in[1] + (size_t)(r - MP) * DM) + F.lane;
            f32x4 v[8]; float sq = 0.f;
#pragma unroll
            for (int j = 0; j < 8; ++j) { v[j] = xr[64 * j]; sq += (v[j].x * v[j].x + v[j].y * v[j].y) + (v[j].z * v[j].z + v[j].w * v[j].w); }
            sq = wave_sum(sq);
            v2u* o = (v2u*)(xb + (size_t)r * DM) + F.lane;
#pragma unroll
            for (int j = 0; j < 8; ++j) { v2u w; w.x = pk2(v[j].x, v[j].y); w.y = pk2(v[j].z, v[j].w); o[64 * j] = w; }
            if (F.lane == 0) ss[r] = sq;
        }
        for (int i = F.bid * NT + F.tid; i < 4 * MPAD; i += F.G * NT) ss[MPAD + i] = 0.f;
        for (int i = F.bid * NT + F.tid; i < MPAD - MT; i += F.G * NT) ss[MT + i] = 0.f;
    }
    if (!tailcopy_ok(F.G)) cache_copy(ka, F, F.bid, F.G);
}

template <bool F32OUT>
__device__ __forceinline__ void phase_norm(const Frame& F, const float* srcp, const float* srcs, const float* gain, bf16* dstb, float* dstp, float* dsts) {
    const int gw = F.bid * NWAVES + F.wave, NGW = F.G * NWAVES;
    f32x4 gv[8];
#pragma unroll
    for (int j = 0; j < 8; ++j) gv[j] = ((const f32x4*)gain)[F.lane + 64 * j];
    for (int r = gw; r < MT; r += NGW) {
        const float* xrow = r < MP ? srcp + (size_t)r * DM : srcs + (size_t)(r - MP) * DM;
        const f32x4* xr = (const f32x4*)xrow + F.lane;
        f32x4 v[8]; float s = 0.f;
#pragma unroll
        for (int j = 0; j < 8; ++j) { v[j] = xr[64 * j]; s += (v[j].x * v[j].x + v[j].y * v[j].y) + (v[j].z * v[j].z + v[j].w * v[j].w); }
        const float rstd = 1.0f / sqrtf(wave_sum(s) * (1.0f / DM) + RMS_EPS);
        if (F32OUT) {
            f32x4* o = (f32x4*)(r < MP ? dstp + (size_t)r * DM : dsts + (size_t)(r - MP) * DM) + F.lane;
#pragma unroll
            for (int j = 0; j < 8; ++j) o[64 * j] = v[j] * rstd * gv[j];
        } else {
            v2u* o = (v2u*)(dstb + (size_t)r * DM) + F.lane;
#pragma unroll
            for (int j = 0; j < 8; ++j) { const f32x4 y = v[j] * rstd * gv[j]; v2u w; w.x = pk2(y.x, y.y); w.y = pk2(y.z, y.w); o[64 * j] = w; }
        }
    }
}

__device__ __forceinline__ void phase_final(const Frame& F, const bf16* xb, const float* ss, const float* gain, float* dstp, float* dsts) {
    const int gw = F.bid * NWAVES + F.wave, NGW = F.G * NWAVES;
    float gn[4][8];
#pragma unroll
    for (int j = 0; j < 4; ++j) ld8f(gain + (j * 64 + F.lane) * 8, gn[j]);
    for (int r = gw; r < MT; r += NGW) {
        const float rstd = 1.0f / sqrtf(ss[r] * (1.0f / DM) + RMS_EPS);
        v4u xv[4];
#pragma unroll
        for (int j = 0; j < 4; ++j) xv[j] = ld16(xb + (size_t)r * DM + (j * 64 + F.lane) * 8);
        float* o = (r < MP ? dstp + (size_t)r * DM : dsts + (size_t)(r - MP) * DM);
#pragma unroll
        for (int j = 0; j < 4; ++j) { float x8[8]; unpack8(xv[j], x8);
#pragma unroll
            for (int e = 0; e < 8; ++e) x8[e] = x8[e] * rstd * gn[j][e];
            st8f(o + (j * 64 + F.lane) * 8, x8); }
    }
}

struct AttItem { int g, dil, rowbase, qcol, k_lo, it, h; };
__device__ __forceinline__ AttItem att_decode(int item) {
    AttItem a; a.g = item >> 8; const int rem = item & 255, b = rem >> 6, sub = rem & 15; a.h = (rem >> 4) & 3;
    a.dil = dil_of(a.g);
    const int r = a.g == 0 ? 0 : (a.g == 1 ? (sub >> 2) : sub); a.it = a.g == 0 ? sub : (a.g == 1 ? (sub & 3) : 0);
    a.rowbase = b * SEQ + r; a.qcol = QKV0 + a.g * 1536 + a.h * 128; a.k_lo = a.it * 128 - 128;
    return a;
}
constexpr int KL_PITCH = 136;
constexpr int KL_OFF = 128 * VT_PITCH * 2;
static_assert(KL_OFF + 256 * KL_PITCH * 2 <= MISC_OFF, "attention LDS images");
__device__ __forceinline__ void att_kvload(const Frame& F, const bf16* proj, const AttItem& a, v4u (&vv)[8], v4u (&kv)[8]) {
    const int kk = F.tid & 255, half = F.tid >> 8, kidx = a.k_lo + kk;
    const bf16* krow = proj + (size_t)(a.rowbase + (kidx >= 0 ? kidx : 0) * a.dil) * INC + a.qcol + 512 + half * 64;
#pragma unroll
    for (int i = 0; i < 8; ++i) kv[i] = ld16(krow + i * 8);
#pragma unroll
    for (int i = 0; i < 8; ++i) vv[i] = ld16(krow + 512 + i * 8);
}
__device__ __forceinline__ void attn_prompt_items(const Frame& F, const bf16* proj, bf16* opart, float* lse) {
    LAS bf16* Vt = (LAS bf16*)F.lds;
    LAS bf16* Kl = (LAS bf16*)(F.lds + KL_OFF);
    const int fr = F.lane & 15, fq = F.lane >> 4;
    int item = F.bid;
    if (item >= 768) return;
    AttItem a = att_decode(item);
    v4u vv[8], kv[8];
    att_kvload(F, proj, a, vv, kv);
    for (;;) {
        const int dil = a.dil, rowbase = a.rowbase, qcol = a.qcol, k_lo = a.k_lo, g = a.g, h = a.h;
        const int q0 = a.it * 128 + 16 * F.wave;
        const float slope = exp2f(-8.0f * (float)(g * 4 + h + 1) / 12.0f);
        const float c1 = 0.08838834764831845f * LOG2E, c2 = slope * (float)dil * LOG2E;
        int dl[4]; float lb[4];
#pragma unroll
        for (int j = 0; j < 4; ++j) { dl[j] = fr - fq * 4 - j; lb[j] = c2 * (float)dl[j]; }
        bf16x8 qf[4];
        { const bf16* qrow = proj + (size_t)(rowbase + (q0 + fr) * dil) * INC + qcol + fq * 8;
#pragma unroll
          for (int ks = 0; ks < 4; ++ks) qf[ks] = *(const bf16x8*)(qrow + ks * 32); }
        {
            const int kk = F.tid & 255, half = F.tid >> 8;
#pragma unroll
            for (int i = 0; i < 8; ++i) *(LAS v4u*)(Kl + (size_t)kk * KL_PITCH + half * 64 + i * 8) = kv[i];
#pragma unroll
            for (int i = 0; i < 8; ++i) { LAS bf16* dst = Vt + (size_t)((half * 8 + i) * 8) * VT_PITCH + kk;
                dst[0 * VT_PITCH] = (bf16)(vv[i].x & 0xffff); dst[1 * VT_PITCH] = (bf16)(vv[i].x >> 16); dst[2 * VT_PITCH] = (bf16)(vv[i].y & 0xffff); dst[3 * VT_PITCH] = (bf16)(vv[i].y >> 16);
                dst[4 * VT_PITCH] = (bf16)(vv[i].z & 0xffff); dst[5 * VT_PITCH] = (bf16)(vv[i].z >> 16); dst[6 * VT_PITCH] = (bf16)(vv[i].w & 0xffff); dst[7 * VT_PITCH] = (bf16)(vv[i].w >> 16); }
        }
        __syncthreads();
        const int nitem = item + F.G; const bool has_next = nitem < 768;
        AttItem an = a;
        if (has_next) { an = att_decode(nitem); att_kvload(F, proj, an, vv, kv); }
        f32x4 st[9];
#pragma unroll
        for (int jt = 0; jt < 9; ++jt) { const int kbase = q0 - 128 + 16 * jt;
            if (kbase >= 0) {
                const LAS bf16* kp = Kl + (size_t)(kbase - k_lo + fr) * KL_PITCH + fq * 8;
                f32x4 acc = (f32x4){0.f, 0.f, 0.f, 0.f};
#pragma unroll
                for (int ks = 0; ks < 4; ++ks) { const bf16x8 kf = *(const LAS bf16x8*)(kp + ks * 32); acc = __builtin_amdgcn_mfma_f32_16x16x32_bf16(kf, qf[ks], acc, 0, 0, 0); }
#pragma unroll
                for (int j = 0; j < 4; ++j) { const float s2 = acc[j] * c1 - (lb[j] + c2 * (float)(128 - 16 * jt));
                    st[jt][j] = ((jt > 0 || dl[j] <= 0) && (jt < 8 || dl[j] >= 0)) ? s2 : -INFINITY; }
            } else st[jt] = (f32x4){-INFINITY, -INFINITY, -INFINITY, -INFINITY};
        }
        float m = -INFINITY;
#pragma unroll
        for (int jt = 0; jt < 9; ++jt) m = fmaxf(fmaxf(fmaxf(st[jt][0], st[jt][1]), fmaxf(st[jt][2], st[jt][3])), m);
        m = fmaxf(m, __shfl_xor(m, 16)); m = fmaxf(m, __shfl_xor(m, 32));
        float lsum = 0.f;
#pragma unroll
        for (int jt = 0; jt < 9; ++jt)
#pragma unroll
            for (int j = 0; j < 4; ++j) { const float p = __builtin_amdgcn_exp2f(st[jt][j] - m); st[jt][j] = p; lsum += p; }
        lsum += __shfl_xor(lsum, 16); lsum += __shfl_xor(lsum, 32);
        f32x4 o[8];
#pragma unroll
        for (int dt = 0; dt < 8; ++dt) o[dt] = (f32x4){0.f, 0.f, 0.f, 0.f};
#pragma unroll
        for (int jt = 0; jt < 9; ++jt) {
            const int kbase = q0 - 128 + 16 * jt;
            if (kbase >= 0) {
                v2u pw; pw.x = pk2(st[jt][0], st[jt][1]); pw.y = pk2(st[jt][2], st[jt][3]);
                const bf16x4 pb = __builtin_bit_cast(bf16x4, pw);
                const LAS bf16* vp = Vt + (size_t)fr * VT_PITCH + (kbase - k_lo) + fq * 4;
#pragma unroll
                for (int dt = 0; dt < 8; ++dt) { const bf16x4 vf = *(const LAS bf16x4*)(vp + (size_t)dt * 16 * VT_PITCH); o[dt] = __builtin_amdgcn_mfma_f32_16x16x16bf16_1k(vf, pb, o[dt], 0, 0, 0); }
            }
        }
        const float inv = 1.0f / lsum;
        const size_t orow = (size_t)(rowbase + (q0 + fr) * dil);
        bf16* op = opart + ((size_t)g * MPAD + orow) * 512 + h * 128 + fq * 4;
#pragma unroll
        for (int dt = 0; dt < 8; ++dt) { v2u w; w.x = pk2(o[dt][0] * inv, o[dt][1] * inv); w.y = pk2(o[dt][2] * inv, o[dt][3] * inv); *(v2u*)(op + dt * 16) = w; }
        if (fq == 0) lse[((size_t)g * MPAD + orow) * 4 + h] = (m + log2f(lsum)) * LN2;
        __syncthreads();
        if (!has_next) break;
        item = nitem; a = an;
    }
}

__device__ __forceinline__ void attn_sample_item(KArgs ka, const Frame& F, int l, const bf16* proj, bf16* opart, float* lse, int item) {
    const int g = item >> 8, rem = item & 255, b = rem >> 5, t = (rem >> 2) & 7, h = rem & 3;
    const int win = win_of(g), dil = dil_of(g);
    const int row = MP + b * DSQ + t;
    const int qcol = QKV0 + g * 1536 + h * 128, kcol = qcol + 512, vcol = qcol + 1024;
    const float* cache = ka->in[2 + g] + ((size_t)(l * DB + b) * win) * 1024;
    LAS float* sc = (LAS float*)(F.lds + 135168 + F.wave * 1024);
    const float slope = exp2f(-8.0f * (float)(g * 4 + h + 1) / 12.0f);
    const float c1 = 0.08838834764831845f * LOG2E, c2 = slope * (float)dil * LOG2E;
    const int sub = F.lane >> 4, li = F.lane & 15;
    const int nnew = t / dil + 1;
    float q8[8]; { float t8[8]; unpack8(ld16(proj + (size_t)row * INC + qcol + li * 8), t8);
#pragma unroll
        for (int e = 0; e < 8; ++e) q8[e] = t8[e] * c1; }
#pragma unroll 1
    for (int j0 = 0; j0 < nnew; j0 += 4) {
        const int j = j0 + sub; float dot = 0.f;
        if (j < nnew) { float k8[8]; unpack8(ld16(proj + (size_t)(row - j * dil) * INC + kcol + li * 8), k8);
#pragma unroll
            for (int e = 0; e < 8; ++e) dot += q8[e] * k8[e]; }
        dot += __shfl_xor(dot, 1); dot += __shfl_xor(dot, 2); dot += __shfl_xor(dot, 4); dot += __shfl_xor(dot, 8);
        if (li == 0 && j < nnew) sc[j] = dot - c2 * (float)j;
    }
    { const float* kb = cache + h * 128 + li * 8;
#pragma unroll 1
      for (int jb = nnew; jb <= 128; jb += 32) {
        float k8[8][8];
#pragma unroll
        for (int i = 0; i < 8; ++i) { const int j = jb + 4 * i + sub; const int jc = j <= 128 ? j : 128; ld8f(kb + (size_t)(win + t - jc * dil) * 1024, k8[i]); }
#pragma unroll
        for (int i = 0; i < 8; ++i) { const int j = jb + 4 * i + sub; float dot = 0.f;
#pragma unroll
            for (int e = 0; e < 8; ++e) dot += q8[e] * k8[i][e];
            dot += __shfl_xor(dot, 1); dot += __shfl_xor(dot, 2); dot += __shfl_xor(dot, 4); dot += __shfl_xor(dot, 8);
            if (li == 0 && j <= 128) sc[j] = dot - c2 * (float)j; }
      } }
    LDS_WAIT();
    float s0 = sc[F.lane], s1 = sc[F.lane + 64], s2 = F.lane == 0 ? sc[128] : -INFINITY;
    const float m = wave_max(fmaxf(fmaxf(s0, s1), s2));
    s0 = exp2f(s0 - m); s1 = exp2f(s1 - m); s2 = F.lane == 0 ? exp2f(s2 - m) : 0.f;
    const float lsum = wave_sum(s0 + s1 + s2);
    sc[F.lane] = s0; sc[F.lane + 64] = s1; if (F.lane == 0) sc[128] = s2;
    LDS_WAIT();
    const int hf = F.lane >> 5, l32 = F.lane & 31;
    f32x4 o = (f32x4){0.f, 0.f, 0.f, 0.f};
#pragma unroll 1
    for (int j = hf; j < nnew; j += 2) { const float p = sc[j]; const v2u w = *(const v2u*)(proj + (size_t)(row - j * dil) * INC + vcol + l32 * 4);
        o += (f32x4){bflo(w.x), bfhi(w.x), bflo(w.y), bfhi(w.y)} * p; }
    { const float* vb = cache + 512 + h * 128 + l32 * 4;
#pragma unroll 1
      for (int jb = nnew; jb <= 128; jb += 32) {
        f32x4 vv[16];
#pragma unroll
        for (int i = 0; i < 16; ++i) { const int j = jb + 2 * i + hf; const int jc = j <= 128 ? j : 128; vv[i] = *(const f32x4*)(vb + (size_t)(win + t - jc * dil) * 1024); }
#pragma unroll
        for (int i = 0; i < 16; ++i) { const int j = jb + 2 * i + hf; const float p = j <= 128 ? sc[j <= 128 ? j : 128] : 0.f; o += vv[i] * p; }
      } }
    o.x += __shfl_xor(o.x, 32); o.y += __shfl_xor(o.y, 32); o.z += __shfl_xor(o.z, 32); o.w += __shfl_xor(o.w, 32);
    const float inv = 1.0f / lsum;
    if (hf == 0) { v2u w; w.x = pk2(o.x * inv, o.y * inv); w.y = pk2(o.z * inv, o.w * inv); *(v2u*)(opart + ((size_t)g * MPAD + row) * 512 + h * 128 + l32 * 4) = w; }
    if (F.lane == 0) lse[((size_t)g * MPAD + row) * 4 + h] = (m + log2f(lsum)) * LN2;
    LDS_WAIT();
}

__device__ __forceinline__ void phase_mixers(KArgs ka, const Frame& F, int l) {
    const bf16* proj = (const bf16*)(ka->ws + WS_PROJ); bf16* ycat = (bf16*)(ka->ws + WS_YCAT);
    bf16* opart = (bf16*)(ka->ws + WS_OPART); float* lse = (float*)(ka->ws + WS_LSE); bf16* dbuf = (bf16*)(ka->ws + WS_DBUF);
    float* outp = ka->out;
    asm volatile("" : "+v"(proj), "+v"(ycat), "+v"(opart), "+v"(lse), "+v"(dbuf), "+v"(outp));
    for (int rep = 0; rep < (MIX_DBL == 1 ? 2 : 1); ++rep) attn_prompt_items(F, proj, opart, lse);
    { const int gw = F.bid * NWAVES + F.wave, NGW = F.G * NWAVES;
      for (int rep = 0; rep < (MIX_DBL == 2 ? 2 : 1); ++rep)
      for (int item = gw; item < 768; item += NGW) attn_sample_item(ka, F, l, proj, opart, lse, item); }
    const int gt = F.bid * NT + F.tid, NGT = F.G * NT;
    { const float* cw = ka->in[10] + (size_t)l * 3 * 512; const float* cst = ka->in[5] + (size_t)l * DB * 2 * 512;
      for (int rep = 0; rep < (MIX_DBL == 3 ? 2 : 1); ++rep)
      for (int q = gt; q < (MT / 4) * 64; q += NGT) {
        const int r0 = (q >> 6) * 4, c = (q & 63) * 8; const bool smp = r0 >= MP;
        const int b = smp ? (r0 - MP) >> 3 : r0 >> 11, t0 = smp ? (r0 - MP) & 7 : r0 & 2047, T = smp ? DSQ : SEQ;
        const bf16* pr = proj + (size_t)r0 * INC + c;
        v4u xa[6], gc[6], gb[4];
#pragma unroll
        for (int i = 0; i < 6; ++i) { const bool ok = t0 + i - 2 >= 0; const bf16* p = pr + (ptrdiff_t)(ok ? i - 2 : 0) * INC; xa[i] = ld16(p); gc[i] = ld16(p + 1024); }
#pragma unroll
        for (int i = 0; i < 4; ++i) gb[i] = ld16(pr + (size_t)i * INC + 512);
        float w0[8], w1[8], w2[8]; ld8f(cw + c, w0); ld8f(cw + 512 + c, w1); ld8f(cw + 1024 + c, w2);
        float p[6][8];
#pragma unroll
        for (int i = 0; i < 6; ++i) { float a8[8], g8[8]; unpack8(xa[i], a8); unpack8(gc[i], g8);
#pragma unroll
            for (int e = 0; e < 8; ++e) p[i][e] = a8[e] * g8[e]; }
        if (t0 == 0) {
            if (smp) { ld8f(cst + ((size_t)b * 2 + 0) * 512 + c, p[0]); ld8f(cst + ((size_t)b * 2 + 1) * 512 + c, p[1]); }
            else {
#pragma unroll
                for (int e = 0; e < 8; ++e) { p[0][e] = 0.f; p[1][e] = 0.f; } }
        }
#pragma unroll
        for (int i = 0; i < 4; ++i) { float g8[8], y[8]; unpack8(gb[i], g8);
#pragma unroll
            for (int e = 0; e < 8; ++e) y[e] = g8[e] * (w0[e] * p[i][e] + w1[e] * p[i + 1][e] + w2[e] * p[i + 2][e]);
            *(v4u*)(ycat + (size_t)(r0 + i) * DM + c) = pack8(y); }
        if (t0 == T - 4) { float* so = outp + (smp ? O_CONVS + (((size_t)l * DB + b) * 2) * 512 : O_CONVP + (((size_t)l * NBATCH + b) * 2) * 512) + c; st8f(so, p[4]); st8f(so + 512, p[5]); }
      } }
    { const float* pst = ka->in[6] + (size_t)l * DB * 15 * 1024;
      for (int rep = 0; rep < (MIX_DBL == 4 ? 2 : 1); ++rep)
      for (int q = gt; q < (MT / 8) * 128; q += NGT) {
        const int r0 = (q >> 7) * 8, c = (q & 127) * 8; const bool smp = r0 >= MP;
        const int b = smp ? (r0 - MP) >> 3 : r0 >> 11, t0 = smp ? 0 : r0 & 2047;
        const int gi = c >> 8;
        const bf16* pr = proj + (size_t)r0 * INC + POOL0 + c;
        bf16* dp = dbuf + ((size_t)gi * MPAD + r0) * 256 + (c & 255);
#define POOL_ITEM(W) { v4u xr[W + 7]; \
        _Pragma("unroll") for (int i = 0; i < W + 7; ++i) { const int rel = i - (W - 1); \
            if (rel >= 0 || (!smp && t0 + rel >= 0)) xr[i] = ld16(pr + (ptrdiff_t)rel * INC); \
            else if (smp) { float f8[8]; ld8f(pst + ((size_t)b * 15 + 15 + rel) * 1024 + c, f8); xr[i] = pack8(f8); } \
            else xr[i] = (v4u){0u, 0u, 0u, 0u}; } \
        float sm[8]; _Pragma("unroll") for (int e = 0; e < 8; ++e) sm[e] = 0.f; \
        _Pragma("unroll") for (int i = 0; i < W - 1; ++i) { float f8[8]; unpack8(xr[i], f8); _Pragma("unroll") for (int e = 0; e < 8; ++e) sm[e] += f8[e]; } \
        _Pragma("unroll") for (int i = 0; i < 8; ++i) { float u8[8], d8[8]; unpack8(xr[i + W - 1], u8); _Pragma("unroll") for (int e = 0; e < 8; ++e) sm[e] += u8[e]; \
            const float rcnt = 1.0f / (float)(smp ? W : min(W, t0 + i + 1)); \
            _Pragma("unroll") for (int e = 0; e < 8; ++e) d8[e] = sm[e] * rcnt - u8[e]; \
            *(v4u*)(dp + (size_t)i * 256) = pack8(d8); \
            if (smp) st8f(outp + O_POOLS + (((size_t)l * DB + b) * 15 + i + 7) * 1024 + c, u8); \
            else if (t0 + i >= SEQ - 15) st8f(outp + O_POOLP + (((size_t)l * NBATCH + b) * 15 + (t0 + i - (SEQ - 15))) * 1024 + c, u8); \
            float o8[8]; unpack8(xr[i], o8); _Pragma("unroll") for (int e = 0; e < 8; ++e) sm[e] -= o8[e]; } }
        if (gi == 0) POOL_ITEM(2) else if (gi == 1) POOL_ITEM(4) else if (gi == 2) POOL_ITEM(8) else POOL_ITEM(16)
#undef POOL_ITEM
        if (smp) {
#pragma unroll
            for (int j = 0; j < 7; ++j) { float x[8]; ld8f(pst + ((size_t)b * 15 + 8 + j) * 1024 + c, x); st8f(outp + O_POOLS + (((size_t)l * DB + b) * 15 + j) * 1024 + c, x); } }
      } }
    const int nsw = (768 + NWAVES - 1) / NWAVES;
    const bool split = F.G >= 2 * nsw;
    const int gt5 = split ? (F.bid - nsw) * NT + F.tid : gt, NGT5 = split ? (F.G - nsw) * NT : NGT;
    if (!split || F.bid >= nsw)
#pragma unroll 1
    for (int g = 0; g < 3; ++g) {
        const int win = win_of(g); const int kvc = QKV0 + g * 1536 + 512;
        const int ntot = (NBATCH * win + MS) * 128;
        for (int rep = 0; rep < (MIX_DBL == 5 ? 2 : 1); ++rep)
        for (int q0 = gt5; q0 < ntot; q0 += 8 * NGT5) {
            v4u x[8]; float* dst[8];
#pragma unroll
            for (int u = 0; u < 8; ++u) { const int q = q0 + u * NGT5; const int qq = q < ntot ? q : 0; const int rr = qq >> 7, c = (qq & 127) * 8; int srow;
                if (rr < NBATCH * win) { const int b = rr / win, i = rr - b * win; srow = b * SEQ + SEQ - win + i; dst[u] = outp + okvp_of(g) + (((size_t)l * NBATCH + b) * win + i) * 1024 + c; }
                else { const int rs = rr - NBATCH * win, b = rs >> 3, i = rs & 7; srow = MP + rs; dst[u] = outp + okvs_of(g) + (((size_t)l * DB + b) * win + win - 8 + i) * 1024 + c; }
                x[u] = ld16(proj + (size_t)srow * INC + kvc + c); }
#pragma unroll
            for (int u = 0; u < 8; ++u) if (q0 + u * NGT5 < ntot) { float f8[8]; unpack8(x[u], f8); st8f(dst[u], f8); }
        }
    }
}

__device__ __forceinline__ void phase_merge(KArgs ka, const Frame& F) {
    const bf16* opart = (const bf16*)(ka->ws + WS_OPART); const float* lse = (const float*)(ka->ws + WS_LSE); bf16* ycat = (bf16*)(ka->ws + WS_YCAT);
    constexpr int NMRG = MT * 64, NPOOLWG = 4 * 33;
    const bool uneven = F.G > NPOOLWG + 32;
    const int CUT = uneven ? (int)((long long)NMRG * (F.G * 14) / (F.G * 14 + (F.G - NPOOLWG) * 12)) : NMRG;
    for (int pass = 0; pass < 2; ++pass) {
    if (pass == 1 && (!uneven || F.bid < NPOOLWG)) break;
    const int gt = pass == 0 ? F.bid * NT + F.tid : CUT + (F.bid - NPOOLWG) * NT + F.tid, NGT = pass == 0 ? F.G * NT : (F.G - NPOOLWG) * NT, qend = pass == 0 ? CUT : NMRG;
    for (int q = gt; q < qend; q += NGT) {
        const int r = q >> 6, c = (q & 63) * 8, h = c >> 7;
        const float l0 = lse[((size_t)0 * MPAD + r) * 4 + h], l1 = lse[((size_t)1 * MPAD + r) * 4 + h], l2 = lse[((size_t)2 * MPAD + r) * 4 + h];
        const float mx = fmaxf(l0, fmaxf(l1, l2));
        float e0 = __expf(l0 - mx), e1 = __expf(l1 - mx), e2 = __expf(l2 - mx); const float inv = 1.0f / (e0 + e1 + e2); e0 *= inv; e1 *= inv; e2 *= inv;
        float x0[8], x1[8], x2[8], y[8];
        unpack8(ld16(opart + ((size_t)0 * MPAD + r) * 512 + c), x0); unpack8(ld16(opart + ((size_t)1 * MPAD + r) * 512 + c), x1); unpack8(ld16(opart + ((size_t)2 * MPAD + r) * 512 + c), x2);
#pragma unroll
        for (int e = 0; e < 8; ++e) y[e] = e0 * x0[e] + e1 * x1[e] + e2 * x2[e];
        *(v4u*)(ycat + (size_t)r * DM + 512 + c) = pack8(y);
    }
    }
}

template <bool BASE_F32, bool OUT_F32> __device__ __forceinline__ void skinny_tile(const Frame& F, const bf16* A, const bf16* Bt, int K, const float* basef, float* outf, int tile, int rh, bf16* xb, float* ss) {
    const int fr = F.lane & 15, fq = F.lane >> 4, n0 = tile * 16, r0 = rh * 32;
    const int nks = K / 32, ks_lo = nks * F.wave / 8, ks_hi = nks * (F.wave + 1) / 8;
    f32x4 acc[2];
#pragma unroll
    for (int m = 0; m < 2; ++m) acc[m] = (f32x4){0.f, 0.f, 0.f, 0.f};
    const bf16* bp = Bt + (size_t)(n0 + fr) * K + fq * 8; const bf16* ap = A + (size_t)(r0 + fr) * K + fq * 8;
#pragma unroll 8
    for (int ks = ks_lo; ks < ks_hi; ++ks) {
        const bf16x8 bv = *(const bf16x8*)(bp + ks * 32);
#pragma unroll
        for (int m = 0; m < 2; ++m) { const bf16x8 av = *(const bf16x8*)(ap + (size_t)m * 16 * K + ks * 32); acc[m] = __builtin_amdgcn_mfma_f32_16x16x32_bf16(av, bv, acc[m], 0, 0, 0); }
    }
    LAS float* red = (LAS float*)F.lds;
#pragma unroll
    for (int m = 0; m < 2; ++m)
#pragma unroll
        for (int j = 0; j < 4; ++j) red[(F.wave * 8 + m * 4 + j) * 64 + F.lane] = acc[m][j];
    __syncthreads();
    { const int idx = F.tid, mj = idx >> 6, ln = idx & 63; float s = 0.f;
#pragma unroll
      for (int w = 0; w < 8; ++w) s += red[(w * 8 + mj) * 64 + ln];
      const int row = r0 + (mj >> 2) * 16 + (ln >> 4) * 4 + (mj & 3), col = n0 + (ln & 15);
      const float v = (BASE_F32 ? basef[(size_t)row * DM + col] : bflo((unsigned)xb[(size_t)row * DM + col])) + s;
      if (OUT_F32) outf[(size_t)row * DM + col] = v;
      else { xb[(size_t)row * DM + col] = (bf16)f2bf(v); float sq = v * v; sq += __shfl_xor(sq, 1); sq += __shfl_xor(sq, 2); sq += __shfl_xor(sq, 4); sq += __shfl_xor(sq, 8); if ((ln & 15) == 0) unsafeAtomicAdd(ss + row, sq); } }
    __syncthreads();
}

__device__ __forceinline__ float silu_mul(float x, float u) { return x / (1.0f + __expf(-x)) * u; }
__device__ __forceinline__ void phase_ffn_act(KArgs ka, const Frame& F, int l) {
    const bf16* gu = (const bf16*)(ka->ws + WS_GU); bf16* abuf = (bf16*)(ka->ws + WS_ABUF);
    const float* cw = ka->in[17] + (size_t)l * 3 * DFF; const float* fst = ka->in[7] + (size_t)l * DB * 2 * DFF;
    const float* halo = (const float*)(ka->ws + WS_FIX); const float* g01 = (const float*)(ka->ws + WS_FIX + FIX_ONE); const float* u01 = (const float*)(ka->ws + WS_FIX + 2 * FIX_ONE);
    const int gt = F.bid * NT + F.tid, NGT = F.G * NT;
    constexpr int NC8 = DFF / 8;
    for (int q = gt; q < (DB + 32) * NC8; q += NGT) {
        const int rc = q / NC8, c = (q - rc * NC8) * 8;
        float w0[8], w1[8], w2[8]; ld8f(cw + c, w0); ld8f(cw + DFF + c, w1); ld8f(cw + 2 * DFF + c, w2);
        if (rc < DB) {
            const int b = rc, r0 = MP + b * 8, gcol = (c >> 7) * 256 + (c & 127);
            const bf16* gp = gu + (size_t)r0 * GUC + gcol;
            v4u gv[8], uv[8];
#pragma unroll
            for (int i = 0; i < 8; ++i) { gv[i] = ld16(gp + (size_t)i * GUC); uv[i] = ld16(gp + (size_t)i * GUC + 128); }
            float g0[8], g1[8], g2[8]; ld8f(fst + ((size_t)b * 2 + 0) * DFF + c, g0); ld8f(fst + ((size_t)b * 2 + 1) * DFF + c, g1);
#pragma unroll
            for (int i = 0; i < 8; ++i) { float u[8], y[8]; unpack8(gv[i], g2); unpack8(uv[i], u);
#pragma unroll
                for (int e = 0; e < 8; ++e) { y[e] = silu_mul(w0[e] * g0[e] + w1[e] * g1[e] + w2[e] * g2[e], u[e]); g0[e] = g1[e]; g1[e] = g2[e]; }
                *(v4u*)(abuf + (size_t)(r0 + i) * DFF + c) = pack8(y); }
            float* so = ka->out + O_FFNS + (((size_t)l * DB + b) * 2) * DFF + c; st8f(so, g0); st8f(so + DFF, g1);
        } else {
            const int pm = rc - DB;
            float g0[8], g1[8], x0[8], x1[8], u0[8], u1[8], y[8];
            if ((pm & 7) == 0) {
#pragma unroll
                for (int e = 0; e < 8; ++e) { g0[e] = 0.f; g1[e] = 0.f; } }
            else { ld8f(halo + (size_t)((pm - 1) * 2 + 0) * DFF + c, g0); ld8f(halo + (size_t)((pm - 1) * 2 + 1) * DFF + c, g1); }
            ld8f(g01 + (size_t)(pm * 2 + 0) * DFF + c, x0); ld8f(g01 + (size_t)(pm * 2 + 1) * DFF + c, x1);
            ld8f(u01 + (size_t)(pm * 2 + 0) * DFF + c, u0); ld8f(u01 + (size_t)(pm * 2 + 1) * DFF + c, u1);
#pragma unroll
            for (int e = 0; e < 8; ++e) y[e] = silu_mul(w0[e] * g0[e] + w1[e] * g1[e] + w2[e] * x0[e], u0[e]);
            *(v4u*)(abuf + (size_t)(pm * 256) * DFF + c) = pack8(y);
#pragma unroll
            for (int e = 0; e < 8; ++e) y[e] = silu_mul(w0[e] * g1[e] + w1[e] * x0[e] + w2[e] * x1[e], u1[e]);
            *(v4u*)(abuf + (size_t)(pm * 256 + 1) * DFF + c) = pack8(y);
        }
    }
}

typedef __attribute__((address_space(1))) unsigned gu32;
#define RLX_AGENT __ATOMIC_RELAXED, __HIP_MEMORY_SCOPE_AGENT
#define XB_TMO      128
#define XB_XCNT(j)  (256  + 64 * (j))
#define XB_XSUB(j)  (1280 + 64 * (j))
#define XB_XGEN(j)  (2304 + 64 * (j))
#define XB_TOP      3328
#define XB_TOPGEN   3392
#define XCD_BAR_WORDS 3456
#define XB_SPIN_CAP (1u << 18)

__device__ __forceinline__ unsigned xb_ld(unsigned* p)              { return __hip_atomic_load(p, __ATOMIC_RELAXED, __HIP_MEMORY_SCOPE_AGENT); }
__device__ __forceinline__ unsigned xb_add(unsigned* p, unsigned v) { return __hip_atomic_fetch_add(p, v, __ATOMIC_RELAXED, __HIP_MEMORY_SCOPE_AGENT); }
__device__ __forceinline__ unsigned xb_xcc_id() { return (unsigned)__builtin_amdgcn_s_getreg((3 << 11) | 20) & 0xFu; }
#define XB_SPIN(cond, bar) do { unsigned _sp = 0; while (cond) { __builtin_amdgcn_s_sleep(1); \
    if ((++_sp & 255u) == 0u) { if (xb_ld(&(bar)[XB_TMO])) break; if (_sp > XB_SPIN_CAP) { atomicAdd(&(bar)[XB_TMO], 1u); break; } } } } while (0)

struct XcdBarrier {
    unsigned* bar; unsigned x;
    volatile LAS unsigned* st;
};

__device__ __forceinline__ XcdBarrier xcd_barrier_post(unsigned* bar, volatile LAS unsigned* st) {
    XcdBarrier b; b.bar = bar; b.x = xb_xcc_id(); b.st = st;
    if (threadIdx.x == 0) (void)xb_add(&bar[XB_XCNT(b.x)], 1u);
    return b;
}
__device__ __forceinline__ void xcd_barrier_complete(unsigned* bar, unsigned x, unsigned& nloc, unsigned& nx) {
    const unsigned G = gridDim.x * gridDim.y * gridDim.z;
    unsigned sum, cnt, mine, sp = 0u;
    for (;;) {
        sum = 0u; cnt = 0u; mine = 0u;
#pragma unroll
        for (unsigned j = 0; j < 16; ++j) { const unsigned c = xb_ld(&bar[XB_XCNT(j)]); sum += c; cnt += (c > 0u) ? 1u : 0u; mine = (j == x) ? c : mine; }
        if (sum == G) break;
        __builtin_amdgcn_s_sleep(1);
        if ((++sp & 255u) == 0u) { if (xb_ld(&bar[XB_TMO])) break; if (sp > XB_SPIN_CAP) { atomicAdd(&bar[XB_TMO], 1u); break; } }
    }
    nloc = mine > 0u ? mine : 1u; nx = cnt > 0u ? cnt : 1u;
}

__device__ __forceinline__ void xcd_barrier(const XcdBarrier& b) {
    asm volatile("s_waitcnt vmcnt(0)" ::: "memory");
    __syncthreads();
    if (threadIdx.x == 0) {
        unsigned* bar = b.bar;
        __builtin_amdgcn_s_waitcnt(0);
        unsigned nloc = b.st[0], nx = b.st[1];
        if (nloc == 0u) { xcd_barrier_complete(bar, b.x, nloc, nx); b.st[0] = nloc; b.st[1] = nx; }
        const unsigned old = xb_add(&bar[XB_XSUB(b.x)], 1u);
        const unsigned gen = old / nloc;
        if (old + 1u == (gen + 1u) * nloc) {
            __builtin_amdgcn_fence(__ATOMIC_RELEASE, "agent");
            asm volatile("s_waitcnt vmcnt(0)" ::: "memory");
            const unsigned og = xb_add(&bar[XB_TOP], 1u);
            const unsigned tg = og / nx;
            if (og + 1u == (tg + 1u) * nx) xb_add(&bar[XB_TOPGEN], 1u);
            else XB_SPIN(xb_ld(&bar[XB_TOPGEN]) == tg, bar);
            __builtin_amdgcn_fence(__ATOMIC_ACQUIRE, "agent");
            xb_add(&bar[XB_XGEN(b.x)], 1u);
            asm volatile("s_waitcnt vmcnt(0)" ::: "memory");
        } else {
            XB_SPIN(xb_ld(&bar[XB_XGEN(b.x)]) == gen, bar);
            __builtin_amdgcn_fence(__ATOMIC_ACQUIRE, "agent");
            asm volatile("s_waitcnt vmcnt(0)" ::: "memory");
        }
    }
    __syncthreads();
}

constexpr int N_PHASES = 16;
#ifndef PHMASK
#define PHMASK 0x3ff
#endif
#define EN(i) (((PHMASK) >> (i)) & 1)
template <int PH> __device__ __forceinline__ void run_phase(KArgs ka, unsigned char* lds_raw) {
    constexpr int l = PH == 0 ? 0 : (PH - 1) / 7, k = PH == 0 ? -1 : (PH == N_PHASES - 1 ? 7 : (PH - 1) % 7);
    asm volatile("" : "+s"(ka));
    Frame F;
    { int tid = threadIdx.x, bid = blockIdx.x, G = gridDim.x; asm volatile("" : "+v"(tid)); asm volatile("" : "+s"(bid), "+s"(G));
      F.lds = (LAS unsigned char*)lds_raw; F.tid = tid; F.lane = tid & 63; F.wave = __builtin_amdgcn_readfirstlane(tid >> 6); F.G = G; F.bid = bid; }
    unsigned char* ws = ka->ws;
    float* xres = (float*)(ws + WS_XRES); bf16* xb = (bf16*)(ws + WS_HB); bf16* proj = (bf16*)(ws + WS_PROJ); bf16* ycat = (bf16*)(ws + WS_YCAT);
    bf16* gu = (bf16*)(ws + WS_GU); bf16* abuf = (bf16*)(ws + WS_ABUF); bf16* dbuf = (bf16*)(ws + WS_DBUF); float* ss = (float*)(ws + WS_SS);
    unsigned char* wl = ws + WS_W + (size_t)l * WL_SIZE;
    if constexpr (k == -1) { if (EN(0)) phase_prep(ka, F); }
    else if constexpr (k == 0) { if (EN(2)) { pg8::Gemm g{xb, (const bf16*)(wl + WL_IN), MPAD, INC, DM}; pg8::StaticOrder S; S.init(MPAD, INC, F.G, F.bid); pg8::EpiStoreBf16 E{proj, INC, ss + (size_t)(2 * l) * MPAD};
        pg8::gemm_phase<pg8::EpiStoreBf16, pg8::StaticOrder, W_IN_ALIGN, true>(F.lds, g, S, E, F.tid);
        if (tailcopy_ok(F.G)) { const int rem = N_UNITS_IN % F.G, rem2 = N_UNITS_GU % F.G, n1 = F.G - rem, n2 = F.G - rem2;
            if (F.bid >= rem) { if (l == 0) convert_items(ka, F, 1, (F.bid - rem) * NWAVES + F.wave, (n1 + n2) * NWAVES); else cache_copy(ka, F, F.bid - rem, n1 + n2); } } } }
    else if constexpr (k == 1) { if (EN(3)) phase_mixers(ka, F, l); }
    else if constexpr (k == 2) { if (EN(4)) { phase_merge(ka, F);
        const int gi = F.bid / 33, pm = F.bid - gi * 33;
        pg8::Gemm g{dbuf + (size_t)(gi & 3) * MPAD * 256, (const bf16*)(wl + WL_PL) + (size_t)(gi & 3) * 65536, MPAD, 256, 256}; pg8::OneUnit S{pm, gi < 4};
        pg8::EpiScaleBf16 E{ycat + 1024 + (gi & 3) * 256, DM, ka->in[13] + (size_t)l * 1024 + (gi & 3) * 256};
        __syncthreads();
        pg8::gemm_phase<pg8::EpiScaleBf16, pg8::OneUnit, false, true>(F.lds, g, S, E, F.tid); } }
    else if constexpr (k == 3 || k == 6) { if (EN(5)) {
        const bf16* A = k == 3 ? ycat : abuf; const bf16* Bt = (const bf16*)(wl + (k == 3 ? WL_OUT : WL_DN)); constexpr int K = k == 3 ? DM : DFF;
        constexpr bool first = (k == 3 && l == 0), last = false;
        float* ssn = ss + (size_t)(2 * l + (k == 3 ? 1 : 2)) * MPAD;
        pg8::Gemm g{A, Bt, MP, DM, K}; pg8::StaticOrder S; S.init(MP, DM, F.G, F.bid); pg8::EpiRes<first, last> E{ka->in[0], xb, xres, xb, ssn, DM};
        pg8::gemm_phase<pg8::EpiRes<first, last>, pg8::StaticOrder, false, true>(F.lds, g, S, E, F.tid);
        __syncthreads();
        for (int t = F.bid; t < 256; t += F.G) skinny_tile<first, last>(F, A + (size_t)MP * K, Bt, K, ka->in[1], xres + (size_t)MP * DM, t & 127, t >> 7, xb + (size_t)MP * DM, ssn + MP); } }
    else if constexpr (k == 4) { if (EN(7)) { pg8::Gemm g{xb, (const bf16*)(wl + WL_GU), MPAD, GUC, DM}; pg8::StaticOrder S; S.init(MPAD, GUC, F.G, F.bid); float* fix = (float*)(ws + WS_FIX);
        pg8::EpiAct E{gu, GUC, abuf, DFF, ss + (size_t)(2 * l + 1) * MPAD, ka->in[17] + (size_t)l * 3 * DFF, fix, fix + FIX_ONE / 4, fix + 2 * (FIX_ONE / 4), ka->out + O_FFNP + (size_t)l * NBATCH * 2 * DFF, (LAS float*)(F.lds + 131072)};
        pg8::gemm_phase<pg8::EpiAct, pg8::StaticOrder, true, true>(F.lds, g, S, E, F.tid);
        if (tailcopy_ok(F.G)) { const int rem = N_UNITS_IN % F.G, rem2 = N_UNITS_GU % F.G, n1 = F.G - rem, n2 = F.G - rem2;
            if (F.bid >= rem2) { if (l == 0) convert_items(ka, F, 1, (n1 + F.bid - rem2) * NWAVES + F.wave, (n1 + n2) * NWAVES); else cache_copy(ka, F, n1 + F.bid - rem2, n1 + n2); } } } }
    else if constexpr (k == 5) { if (EN(8)) phase_ffn_act(ka, F, l); }
    else { if (EN(9)) phase_final(F, xb, ss + (size_t)4 * MPAD, ka->in[19], ka->out + O_YP, ka->out + O_YS); }
}
__global__ void __launch_bounds__(NT, 2) hymba_fwd(Args a_unused) {
    extern __shared__ __attribute__((aligned(16))) unsigned char lds_raw[];
    cg::grid_group grid = cg::this_grid();
    KArgs ka = (KArgs)__builtin_amdgcn_kernarg_segment_ptr();
    const int ph_lo = ka->ph_lo, ph_hi = ka->ph_hi;
    { volatile LAS unsigned* misc = (volatile LAS unsigned*)((LAS unsigned char*)lds_raw + MISC_OFF); if (threadIdx.x < 4) misc[threadIdx.x] = 0u; }
    __syncthreads();
    const XcdBarrier xbar = xcd_barrier_post((unsigned*)ka->ws, (volatile LAS unsigned*)((LAS unsigned char*)lds_raw + MISC_OFF));
#define SEAM(P) do { if (ph_hi > N_PHASES) grid.sync(); else xcd_barrier(xbar); } while (0)
#ifndef DBL_PH
#define DBL_PH -1
#endif
#ifndef XSYNC
#define XSYNC 0
#endif
#define RUN(P) if (ph_lo <= (P) && (P) < ph_hi) { if ((P) == DBL_PH) { run_phase<P>(ka, lds_raw); SEAM(P); } run_phase<P>(ka, lds_raw); if ((P) + 1 < ph_hi) SEAM(P); }
    RUN(0) RUN(1) RUN(2) RUN(3) RUN(4) RUN(5) RUN(6) RUN(7) RUN(8) RUN(9)
    RUN(10) RUN(11) RUN(12) RUN(13) RUN(14) RUN(15)
#undef RUN
    for (int i = 0; i < XSYNC; ++i) xcd_barrier(xbar);
}

extern "C" void kernel_launch(void* const* d_in, const int* in_sizes, int n_in, void* d_out, int out_size, void* d_ws, size_t ws_size, hipStream_t stream) {
    static int grid = 0;
    if (grid == 0) {
        if (n_in != 20 || (size_t)out_size != O_END || ws_size < WS_END) { fprintf(stderr, "kernel_launch: unexpected sizes: n_in %d out %d ws %zu (need %zu)\n", n_in, out_size, ws_size, (size_t)WS_END); grid = -1; return; }
        int dev = 0, cus = 0, per_cu = 0;
        if (hipGetDevice(&dev) != hipSuccess || hipDeviceGetAttribute(&cus, hipDeviceAttributeMultiprocessorCount, dev) != hipSuccess) { grid = -1; return; }
        if (hipFuncSetAttribute((const void*)hymba_fwd, hipFuncAttributeMaxDynamicSharedMemorySize, LDS_BYTES) != hipSuccess) { fprintf(stderr, "kernel_launch: hipFuncSetAttribute failed\n"); grid = -1; return; }
        if (hipOccupancyMaxActiveBlocksPerMultiprocessor(&per_cu, (const void*)hymba_fwd, NT, LDS_BYTES) != hipSuccess || per_cu < 1) { fprintf(stderr, "kernel_launch: occupancy query says %d\n", per_cu); (void)hipGetLastError(); grid = -1; return; }
        grid = cus * 1;
    }
    if (grid < 0) return;
    if (hipMemsetAsync(d_ws, 0, CTL_ZERO_BYTES, stream) != hipSuccess) { fprintf(stderr, "kernel_launch: memset failed\n"); return; }
    Args a{};
    for (int i = 0; i < 20; ++i) a.in[i] = (const float*)d_in[i];
    a.out = (float*)d_out; a.ws = (unsigned char*)d_ws;
#if MK_PER_PHASE
    for (int ph = 0; ph < N_PHASES; ++ph) { a.ph_lo = ph; a.ph_hi = ph + 1; void* args[] = {&a};
        hipError_t e = hipLaunchCooperativeKernel((const void*)hymba_fwd, dim3(grid), dim3(NT), args, LDS_BYTES, stream);
        if (e != hipSuccess) { fprintf(stderr, "cooperative launch failed: %s\n", hipGetErrorString(e)); break; } }
#else
    a.ph_lo = 0; a.ph_hi = N_PHASES; void* args[] = {&a};
    hipError_t e = hipLaunchCooperativeKernel((const void*)hymba_fwd, dim3(grid), dim3(NT), args, LDS_BYTES, stream);
    if (e != hipSuccess) fprintf(stderr, "cooperative launch failed: %s (grid %d)\n", hipGetErrorString(e), grid);
#endif
}
```
